# Optimizing an MI355X kernel written in HIP

```python
import jax, jax.numpy as jnp
from jax import lax
import numpy as np

D_MODEL = 1024
BATCH = 4
SEQ = 8192
DEPTH = 2

EPS = 1e-6
ROPE_THETA = 10000.0
BLOCK = 128
MLA_HEADS = 4
MLA_Q_RANK = 256
MLA_KV_RANK = 128
MLA_NOPE = 128
MLA_ROPE = 64
MLA_V = 128
MLA_QK = MLA_NOPE + MLA_ROPE
MLA_WIDTH = MLA_HEADS * MLA_V
SWA_HEADS = 8
SWA_KV_HEADS = 2
SWA_HEAD_DIM = 64
WINDOW = 128
SWA_WIDTH = SWA_HEADS * SWA_HEAD_DIM
MIX_WIDTH = MLA_WIDTH + SWA_WIDTH
IN_SPLITS = (MLA_Q_RANK, MLA_KV_RANK, MLA_ROPE,
             SWA_HEADS * SWA_HEAD_DIM, SWA_KV_HEADS * SWA_HEAD_DIM, SWA_KV_HEADS * SWA_HEAD_DIM)
IN_COLS = sum(IN_SPLITS)
D_FF = 2816

kernel_name = "hybrid_mla_swa_sink_macaron"


def rmsnorm(t, g):
    tf = t.astype(jnp.float32)
    out = tf * lax.rsqrt(jnp.mean(tf * tf, axis=-1, keepdims=True) + EPS)
    return (out * g.astype(jnp.float32)).astype(t.dtype)


def swiglu(t, w_gate, w_up, w_down):
    return (jax.nn.silu(t @ w_gate) * (t @ w_up)) @ w_down


def rope_table(seq, dim):
    pos = jnp.arange(seq, dtype=jnp.float32)
    inv = 1.0 / (ROPE_THETA ** (jnp.arange(0, dim, 2, dtype=jnp.float32) / dim))
    ang = pos[:, None] * inv[None, :]
    return jnp.cos(ang), jnp.sin(ang)


def apply_rope(t, cos, sin):
    half = t.shape[-1] // 2
    t1 = t[..., :half].astype(jnp.float32)
    t2 = t[..., half:].astype(jnp.float32)
    c = cos[None, :, None, :]
    s = sin[None, :, None, :]
    return jnp.concatenate([t1 * c - t2 * s, t2 * c + t1 * s], axis=-1).astype(t.dtype)


def dense_causal_attention(q, k, v, scale):
    B, S, H, Dq = q.shape
    nb = S // BLOCK
    qb = q.reshape(B, nb, BLOCK, H, Dq).transpose(1, 0, 2, 3, 4)
    k_pos = jnp.arange(S)

    def one_block(args):
        q_blk, i = args
        s = jnp.einsum('bqhd,bkhd->bhqk', q_blk, k, preferred_element_type=jnp.float32) * scale
        q_pos = i * BLOCK + jnp.arange(BLOCK)
        mask = k_pos[None, :] <= q_pos[:, None]
        s = jnp.where(mask[None, None], s, -jnp.inf)
        p = jax.nn.softmax(s, axis=-1)
        return jnp.einsum('bhqk,bkhd->bqhd', p.astype(v.dtype), v)

    out = lax.map(one_block, (qb, jnp.arange(nb)))
    return out.transpose(1, 0, 2, 3, 4).reshape(B, S, H, v.shape[-1])


def sliding_window_sink_attention(q, k, v, sinks, scale):
    B, S, H, D = q.shape
    KV = k.shape[2]
    G = H // KV
    nb = S // BLOCK
    qb = q.reshape(B, nb, BLOCK, KV, G, D)

    def band(t):
        tb = t.reshape(B, nb, BLOCK, KV, D)
        prev = jnp.pad(tb[:, :-1], ((0, 0), (1, 0), (0, 0), (0, 0), (0, 0)))
        return jnp.concatenate([prev, tb], axis=2)

    kb, vb = band(k), band(v)
    s = jnp.einsum('bnqcgd,bnkcd->bncgqk', qb, kb, preferred_element_type=jnp.float32) * scale
    q_rel = jnp.arange(BLOCK)[:, None] + BLOCK
    k_rel = jnp.arange(2 * BLOCK)[None, :]
    dist = q_rel - k_rel
    in_window = (dist >= 0) & (dist < WINDOW)
    k_abs = jnp.arange(nb)[:, None, None] * BLOCK + k_rel[None] - BLOCK
    valid = in_window[None] & (k_abs >= 0)
    s = jnp.where(valid[None, :, None, None], s, -jnp.inf)
    sink = sinks.astype(jnp.float32).reshape(KV, G)[None, None, :, :, None, None]
    m = jnp.maximum(jnp.max(s, axis=-1, keepdims=True), sink)
    e = jnp.exp(s - m)
    p = e / (jnp.sum(e, axis=-1, keepdims=True) + jnp.exp(sink - m))
    out = jnp.einsum('bncgqk,bnkcd->bnqcgd', p.astype(v.dtype), vb)
    return out.reshape(B, S, H, D)


def setup_inputs(seed: int = 0) -> dict:
    key = jax.random.key(seed)
    ks = iter(jax.random.split(key, 32))

    def w(shape, fan_in):
        return jax.random.normal(next(ks), shape, jnp.float32) * (fan_in ** -0.5)

    def gain(shape):
        return 1.0 + 0.02 * jax.random.normal(next(ks), shape, jnp.float32)

    L = DEPTH
    return {
        "x": jax.random.normal(next(ks), (BATCH, SEQ, D_MODEL), jnp.float32),
        "ffn1_norm": gain((L, D_MODEL)),
        "ffn1_w_gate": w((L, D_MODEL, D_FF), D_MODEL),
        "ffn1_w_up": w((L, D_MODEL, D_FF), D_MODEL),
        "ffn1_w_down": w((L, D_FF, D_MODEL), D_FF),
        "mix_norm": gain((L, D_MODEL)),
        "w_in": w((L, D_MODEL, IN_COLS), D_MODEL),
        "mla_q_a_norm": gain((L, MLA_Q_RANK)),
        "mla_w_q_b": w((L, MLA_Q_RANK, MLA_HEADS * MLA_QK), MLA_Q_RANK),
        "mla_kv_a_norm": gain((L, MLA_KV_RANK)),
        "mla_w_kv_b": w((L, MLA_KV_RANK, MLA_HEADS * (MLA_NOPE + MLA_V)), MLA_KV_RANK),
        "mla_q_norm": gain((L, MLA_QK)),
        "mla_k_norm": gain((L, MLA_QK)),
        "swa_q_norm": gain((L, SWA_HEAD_DIM)),
        "swa_k_norm": gain((L, SWA_HEAD_DIM)),
        "swa_sinks": 0.5 * jax.random.normal(next(ks), (L, SWA_HEADS), jnp.float32),
        "mla_out_norm": gain((L, MLA_WIDTH)),
        "swa_out_norm": gain((L, SWA_WIDTH)),
        "w_o": w((L, MIX_WIDTH, D_MODEL), MIX_WIDTH),
        "ffn2_norm": gain((L, D_MODEL)),
        "ffn2_w_gate": w((L, D_MODEL, D_FF), D_MODEL),
        "ffn2_w_up": w((L, D_MODEL, D_FF), D_MODEL),
        "ffn2_w_down": w((L, D_FF, D_MODEL), D_FF),
    }


def reference(x, ffn1_norm, ffn1_w_gate, ffn1_w_up, ffn1_w_down, mix_norm, w_in,
              mla_q_a_norm, mla_w_q_b, mla_kv_a_norm, mla_w_kv_b, mla_q_norm, mla_k_norm,
              swa_q_norm, swa_k_norm, swa_sinks, mla_out_norm, swa_out_norm, w_o,
              ffn2_norm, ffn2_w_gate, ffn2_w_up, ffn2_w_down):
    B, S, _ = x.shape
    cos, sin = rope_table(S, MLA_ROPE)
    split_idx = np.cumsum(IN_SPLITS)[:-1].tolist()
    mla_scale = MLA_QK ** -0.5
    swa_scale = SWA_HEAD_DIM ** -0.5

    for l in range(DEPTH):
        x = x + 0.5 * swiglu(rmsnorm(x, ffn1_norm[l]), ffn1_w_gate[l], ffn1_w_up[l], ffn1_w_down[l])

        h = rmsnorm(x, mix_norm[l])
        c_q, c_kv, k_pe, q_s, k_s, v_s = jnp.split(h @ w_in[l], split_idx, axis=-1)

        q_a = (rmsnorm(c_q, mla_q_a_norm[l]) @ mla_w_q_b[l]).reshape(B, S, MLA_HEADS, MLA_QK)
        kv_a = (rmsnorm(c_kv, mla_kv_a_norm[l]) @ mla_w_kv_b[l]).reshape(B, S, MLA_HEADS, MLA_NOPE + MLA_V)
        k_nope, v_a = kv_a[..., :MLA_NOPE], kv_a[..., MLA_NOPE:]
        k_a = jnp.concatenate(
            [k_nope, jnp.broadcast_to(k_pe[:, :, None, :], (B, S, MLA_HEADS, MLA_ROPE))], axis=-1)
        q_a = rmsnorm(q_a, mla_q_norm[l])
        k_a = rmsnorm(k_a, mla_k_norm[l])
        q_a = jnp.concatenate([q_a[..., :MLA_NOPE], apply_rope(q_a[..., MLA_NOPE:], cos, sin)], axis=-1)
        k_a = jnp.concatenate([k_a[..., :MLA_NOPE], apply_rope(k_a[..., MLA_NOPE:], cos, sin)], axis=-1)
        out_a = dense_causal_attention(q_a, k_a, v_a, mla_scale).reshape(B, S, MLA_WIDTH)

        q_b = rmsnorm(q_s.reshape(B, S, SWA_HEADS, SWA_HEAD_DIM), swa_q_norm[l])
        k_b = rmsnorm(k_s.reshape(B, S, SWA_KV_HEADS, SWA_HEAD_DIM), swa_k_norm[l])
        v_b = v_s.reshape(B, S, SWA_KV_HEADS, SWA_HEAD_DIM)
        q_b = apply_rope(q_b, cos, sin)
        k_b = apply_rope(k_b, cos, sin)
        out_b = sliding_window_sink_attention(q_b, k_b, v_b, swa_sinks[l], swa_scale).reshape(B, S, SWA_WIDTH)

        mixed = jnp.concatenate([rmsnorm(out_a, mla_out_norm[l]), rmsnorm(out_b, swa_out_norm[l])], axis=-1)
        x = x + mixed @ w_o[l]

        x = x + 0.5 * swiglu(rmsnorm(x, ffn2_norm[l]), ffn2_w_gate[l], ffn2_w_up[l], ffn2_w_down[l])
    return x
```

```cpp
#include <hip/hip_runtime.h>
#include <hip/hip_cooperative_groups.h>
#include <cstdio>
#include <cstdint>
namespace cg = cooperative_groups;

#define LAS __attribute__((address_space(3)))
typedef unsigned short bf16_t;
typedef short bf16x8 __attribute__((ext_vector_type(8)));
typedef short s16x4 __attribute__((ext_vector_type(4)));
typedef float f32x4 __attribute__((ext_vector_type(4)));
typedef float f32x16 __attribute__((ext_vector_type(16)));
typedef unsigned u32x4 __attribute__((ext_vector_type(4)));

constexpr int DM = 1024, BATCH = 4, SEQ = 8192, DEPTH = 2, MTOK = BATCH * SEQ;
constexpr int DFF = 2816, INC = 1216;
constexpr float EPS = 1e-6f;
constexpr int NWAVES = 8, NTHR = 512;
constexpr int LDS_BYTES = 147456;

constexpr size_t MiB = 1u << 20;
constexpr size_t WS_W = 0, W_LAYER = 39 * MiB;
constexpr size_t OW_1T = 0, OW_1D = 11 * MiB, OW_2T = 16 * MiB + MiB / 2, OW_2D = 27 * MiB + MiB / 2, OW_IN = 33 * MiB, OW_O = 36 * MiB,
                 OW_QB = 38 * MiB, OW_KVB = 38 * MiB + 393216;
constexpr size_t WS_XSS = 78 * MiB, WS_CSS = 80 * MiB, WS_OSS = 82 * MiB;
constexpr size_t WS_XB = 84 * MiB;
constexpr size_t WS_ACT = 148 * MiB;
constexpr size_t WS_P = 148 * MiB, WS_KM = 232 * MiB, WS_QS = 280 * MiB, WS_KS = 312 * MiB;
constexpr size_t WS_QAKV = 324 * MiB;
constexpr size_t WS_MIX = 436 * MiB;
constexpr size_t WS_CTL = 500 * MiB, CTL_BYTES = 16384;
constexpr size_t WS_ROPE = 501 * MiB;
constexpr size_t WS_END = 503 * MiB;

__device__ __forceinline__ unsigned cvt_pk_bf16(float lo, float hi) { unsigned r; asm volatile("v_cvt_pk_bf16_f32 %0, %1, %2" : "=v"(r) : "v"(lo), "v"(hi)); return r; }
__device__ __forceinline__ float bf2f(bf16_t v) { return __uint_as_float(((unsigned)v) << 16); }
__device__ __forceinline__ bf16_t f2bf(float f) { return (bf16_t)(cvt_pk_bf16(f, 0.f) & 0xffffu); }
template <int M> __device__ __forceinline__ float shx(float v) {
    if constexpr (M == 32) { auto rr = __builtin_amdgcn_permlane32_swap(__float_as_uint(v), __float_as_uint(v), false, false);
        return __uint_as_float(rr[0]) == v ? __uint_as_float(rr[1]) : __uint_as_float(rr[0]); }
    else return __uint_as_float((unsigned)__builtin_amdgcn_ds_swizzle((int)__float_as_uint(v), 0x1F | (M << 10)));
}
__device__ __forceinline__ int lane_id_v() { int l; asm volatile("v_mbcnt_lo_u32_b32 %0, -1, 0\n\tv_mbcnt_hi_u32_b32 %0, -1, %0" : "=v"(l)); return l; }
__device__ __forceinline__ int tid_now(int wv) { return wv * 64 + lane_id_v(); }
__device__ __forceinline__ float wave_sum(float v) {
    v += shx<1>(v); v += shx<2>(v); v += shx<4>(v); v += shx<8>(v); v += shx<16>(v);
    { auto rr = __builtin_amdgcn_permlane32_swap(__float_as_uint(v), __float_as_uint(v), false, false); v = __uint_as_float(rr[0]) + __uint_as_float(rr[1]); }
    return v;
}

namespace pg8 {
constexpr int BM = 256, BK = 64, HALF = 128, HTB = HALF * BK * 2, NXCD = 8, WGM = 8;
__host__ __device__ __forceinline__ int lds_byte(int r, int c) { const int st = (r >> 4) * 2 + (c >> 5), rr = r & 15, cc = c & 31, ob = rr * 64 + cc * 2; return st * 1024 + (ob ^ (((ob >> 9) & 1) << 5)); }
__host__ __device__ __forceinline__ void stage_rc(int b, int& R, int& C) { const int st = b / 1024, sb = b % 1024, swz = sb ^ (((sb >> 9) & 1) << 5); R = (st >> 1) * 16 + swz / 64; C = (st & 1) * 32 + (swz % 64) / 2; }
__host__ __device__ __forceinline__ int perm32(int rho) { const int n = rho >> 4, i = rho & 15; return 8 * (i >> 2) + 4 * n + (i & 3); }

struct Unit { int pm, pn; };
struct Gemm { const bf16_t* A; const bf16_t* Bt; int lda, ldb, M, N, K; };

struct StaticOrder {
    int nM, nN, nwg, G, c;
    __device__ void init(int M, int N, int G_, int c_) { nM = M / BM; nN = N / BM; nwg = nM * nN; G = G_; c = c_; }
    __device__ bool next(int i, Unit& u) const {
        const long L = (long)i * G + c; if (L >= nwg) return false;
        int wgid = (int)L; { const int q = nwg / NXCD, r = nwg % NXCD, xcd = wgid % NXCD, off = wgid / NXCD; wgid = (xcd < r ? xcd * (q + 1) : r * (q + 1) + (xcd - r) * q) + off; }
        const int nig = WGM * nN, gid = wgid / nig, fm = gid * WGM, gsz = (nM - fm) < WGM ? (nM - fm) : WGM;
        u.pm = fm + ((wgid % nig) % gsz); u.pn = (wgid % nig) / gsz; return true;
    }
};

enum { MODE_SWIGLU = 0, MODE_RESID = 1, MODE_SCALE = 2 };
struct Epi {
    int mode;
    const float* stats; int np4; float inv_n;
    float alpha;
    const float* res; float* outf; bf16_t* outb; int ldc; int ncols; float* ssq; int wb;
    const float* mstats; int mid_t;
    __device__ __forceinline__ void mid(f32x4 (&acc)[2][2][4][2], const Unit& u, int wr, int fr, const LAS float* rsl) const {
#pragma unroll
        for (int ai = 0; ai < 2; ++ai)
#pragma unroll
            for (int m = 0; m < 4; ++m) {
                const float ratio = rsl[BM + ai * HALF + wr * 64 + m * 16 + fr];
#pragma unroll
                for (int bj = 0; bj < 2; ++bj)
#pragma unroll
                    for (int n = 0; n < 2; ++n) acc[ai][bj][m][n] = acc[ai][bj][m][n] * ratio;
            }
    }
    __device__ __forceinline__ void pre(const Unit& u, int wr, int fr, int tid, LAS float* rsl, int& cached_pm, float (&rs)[2][4]) const {
        if (np4 == 0) {
#pragma unroll
            for (int ai = 0; ai < 2; ++ai)
#pragma unroll
                for (int m = 0; m < 4; ++m) rs[ai][m] = alpha;
            return;
        }
        if (u.pm != cached_pm) {
            __builtin_amdgcn_s_barrier();
            if (tid < BM) { const float* sp = stats + (size_t)(u.pm * BM + tid) * 16; float t = 0.f;
                for (int q = 0; q < np4; ++q) { const f32x4 v = *(const f32x4*)(sp + 4 * q); t += (v[0] + v[1]) + (v[2] + v[3]); }
                float eps_ = EPS; asm volatile("" : "+s"(eps_));
                const float rb = rsqrtf(t * inv_n + eps_); rsl[tid] = rb;
                if (mstats) { const f32x4 a = *(const f32x4*)(mstats + (size_t)(u.pm * BM + tid) * 16); rsl[BM + tid] = rsqrtf(((a[0] + a[1]) + (a[2] + a[3])) * (1.f / 512.f) + eps_) / rb; } }
            asm volatile("s_waitcnt lgkmcnt(0)" ::: "memory");
            __builtin_amdgcn_s_barrier();
            cached_pm = u.pm;
        }
#pragma unroll
        for (int ai = 0; ai < 2; ++ai)
#pragma unroll
            for (int m = 0; m < 4; ++m) rs[ai][m] = rsl[ai * HALF + wr * 64 + m * 16 + fr] * alpha;
#pragma unroll
        for (int ai = 0; ai < 2; ++ai)
#pragma unroll
            for (int m = 0; m < 4; ++m) asm volatile("" : "+v"(rs[ai][m]));
    }
    __device__ __forceinline__ void operator()(const f32x4 (&acc)[2][2][4][2], const Unit& u, int wr, int wc, int fr, int fq, const float (&rs)[2][4]) const {
        const int row0 = u.pm * BM + wr * 64 + fr;
        if (mode == MODE_SWIGLU) {
            const int col0 = u.pn * 128 + wc * 32 + 8 * fq;
#pragma unroll
            for (int ai = 0; ai < 2; ++ai)
#pragma unroll
                for (int m = 0; m < 4; ++m) {
                    const int r = row0 + ai * HALF + m * 16; const float s = rs[ai][m], sl = s * -1.4426950408889634f, s2 = s * s;
                    float a[8];
#pragma unroll
                    for (int n = 0; n < 2; ++n)
#pragma unroll
                        for (int j = 0; j < 4; ++j) { const float ga = acc[ai][0][m][n][j], ua = acc[ai][1][m][n][j];
                            const float e = __builtin_amdgcn_exp2f(ga * sl), gu = (ga * ua) * s2;
                            a[4 * n + j] = gu * __builtin_amdgcn_rcpf(1.f + e); }
                    u32x4 w; w.x = cvt_pk_bf16(a[0], a[1]); w.y = cvt_pk_bf16(a[2], a[3]); w.z = cvt_pk_bf16(a[4], a[5]); w.w = cvt_pk_bf16(a[6], a[7]);
                    *(u32x4*)(outb + (size_t)r * ldc + col0) = w;
                }
        } else if (mode == MODE_RESID) {
            {
#define RLD(dst, it) do { if (!res) { _Pragma("unroll") for (int bj = 0; bj < 2; ++bj) dst[bj] = *(const u32x4*)(outb + (size_t)(row0 + ((it) >> 2) * HALF + ((it) & 3) * 16) * ldc + u.pn * BM + bj * HALF + wc * 32 + 8 * fq); } } while (0)
                u32x4 xc[2];
                RLD(xc, 0);
#pragma unroll
                for (int it = 0; it < 8; ++it) {
                    const int ai = it >> 2, m = it & 3;
                    const int r = row0 + ai * HALF + m * 16; const float s = rs[ai][m]; float sq = 0.f;
                    f32x4 v[2][2]; u32x4 w[2];
#pragma unroll
                    for (int bj = 0; bj < 2; ++bj) {
                        f32x4 x0, x1;
                        if (res) { const float* p = res + (size_t)r * ldc + u.pn * BM + bj * HALF + wc * 32 + 8 * fq; x0 = *(const f32x4*)p; x1 = *(const f32x4*)(p + 4); }
                        else { const u32x4 t = xc[bj];
                            x0 = (f32x4){__uint_as_float(t.x << 16), __uint_as_float(t.x & 0xffff0000u), __uint_as_float(t.y << 16), __uint_as_float(t.y & 0xffff0000u)};
                            x1 = (f32x4){__uint_as_float(t.z << 16), __uint_as_float(t.z & 0xffff0000u), __uint_as_float(t.w << 16), __uint_as_float(t.w & 0xffff0000u)}; }
                        v[bj][0] = x0 + acc[ai][bj][m][0] * s; v[bj][1] = x1 + acc[ai][bj][m][1] * s;
                        w[bj].x = cvt_pk_bf16(v[bj][0][0], v[bj][0][1]); w[bj].y = cvt_pk_bf16(v[bj][0][2], v[bj][0][3]); w[bj].z = cvt_pk_bf16(v[bj][1][0], v[bj][1][1]); w[bj].w = cvt_pk_bf16(v[bj][1][2], v[bj][1][3]);
                        sq += (v[bj][0][0] * v[bj][0][0] + v[bj][0][1] * v[bj][0][1]) + (v[bj][0][2] * v[bj][0][2] + v[bj][0][3] * v[bj][0][3]) + (v[bj][1][0] * v[bj][1][0] + v[bj][1][1] * v[bj][1][1]) + (v[bj][1][2] * v[bj][1][2] + v[bj][1][3] * v[bj][1][3]);
                    }
                    if (it + 1 < 8) RLD(xc, it + 1);
#pragma unroll
                    for (int bj = 0; bj < 2; ++bj) {
                        const int c0 = u.pn * BM + bj * HALF + wc * 32 + 8 * fq;
                        if (outf) { *(f32x4*)(outf + (size_t)r * ldc + c0) = v[bj][0]; *(f32x4*)(outf + (size_t)r * ldc + c0 + 4) = v[bj][1]; }
                        *(u32x4*)(outb + (size_t)r * ldc + c0) = w[bj];
                    }
                    sq += shx<16>(sq); { auto rr_ = __builtin_amdgcn_permlane32_swap(__float_as_uint(sq), __float_as_uint(sq), false, false); sq = __uint_as_float(rr_[0]) + __uint_as_float(rr_[1]); }
                    if (fq == 0) ssq[(size_t)r * 16 + u.pn * 4 + wc] = sq;
                }
#undef RLD
            }
        } else {
            const bool do_ss = (ssq != nullptr) && (u.pn < 2);
#pragma unroll
            for (int ai = 0; ai < 2; ++ai)
#pragma unroll
                for (int m = 0; m < 4; ++m) {
                    const int r = row0 + ai * HALF + m * 16; const float s = rs[ai][m]; float sq = 0.f;
#pragma unroll
                    for (int bj = 0; bj < 2; ++bj) {
                        const int c0 = u.pn * BM + bj * HALF + wc * 32 + 8 * fq;
                        const f32x4 v0 = acc[ai][bj][m][0] * s, v1 = acc[ai][bj][m][1] * s;
                        if (c0 < ncols) {
                            u32x4 w; w.x = cvt_pk_bf16(v0[0], v0[1]); w.y = cvt_pk_bf16(v0[2], v0[3]); w.z = cvt_pk_bf16(v1[0], v1[1]); w.w = cvt_pk_bf16(v1[2], v1[3]);
                            *(u32x4*)(outb + (size_t)r * ldc + c0) = w;
                        }
                        if (bj == 0 || u.pn == 0)
                            sq += (v0[0] * v0[0] + v0[1] * v0[1]) + (v0[2] * v0[2] + v0[3] * v0[3]) + (v1[0] * v1[0] + v1[1] * v1[1]) + (v1[2] * v1[2] + v1[3] * v1[3]);
                    }
                    if (do_ss) { sq += shx<16>(sq); { auto rr_ = __builtin_amdgcn_permlane32_swap(__float_as_uint(sq), __float_as_uint(sq), false, false); sq = __uint_as_float(rr_[0]) + __uint_as_float(rr_[1]); } if (fq == 0) ssq[(size_t)r * 16 + u.pn * 4 + wc] = sq; }
                }
        }
    }
};

__device__ __forceinline__ void gemm_phase(LAS unsigned char* lds, const Gemm g, const StaticOrder& S, const Epi& E, int wv) {
    const int tid_ = tid_now(wv);
    const int tid = tid_, wid = __builtin_amdgcn_readfirstlane(tid >> 6), lane = tid & 63, wr = wid >> 2, wc = wid & 3, fr = lane & 15, fq = lane >> 4;
    const int K = g.K, nt = K / BK;
    unsigned voffA[2], voffB[2];
#pragma unroll
    for (int i = 0; i < 2; ++i) { int R, C; stage_rc(tid * 16 + i * 8192, R, C); const int Rb = (R & ~31) + perm32(R & 31);
        voffA[i] = (unsigned)(R * g.lda + C) * 2u; voffB[i] = (unsigned)(Rb * g.ldb + C) * 2u; }
    const size_t kstep = (size_t)(BK * 2);
    const size_t hstepA = (size_t)HALF * g.lda * 2, hstepB = (size_t)HALF * g.ldb * 2;
    const size_t tstepA = 2 * hstepA, tstepB = 2 * hstepB;
    const unsigned ldsw = (unsigned)wid * 1024u;
    const int aoff = lds_byte(wr * 64 + fr, fq * 8), boff = lds_byte(wc * 32 + fr, fq * 8);
#define PG8_SA(b, h) (((b) * 2 + (h)) * HTB)
#define PG8_SB(b, h) ((4 + (b) * 2 + (h)) * HTB)
#define PG8_STAGE(bufoff, gbase, voff) do { _Pragma("unroll") for (int _i = 0; _i < 2; ++_i) \
        __builtin_amdgcn_global_load_lds((const unsigned*)((const char*)(gbase) + (voff)[_i]), (LAS unsigned*)(lds + (bufoff) + ldsw + _i * 8192), 16, 0, 0); } while (0)
#define PG8_LDA(dst, b, h) do { _Pragma("unroll") for (int m = 0; m < 4; ++m) _Pragma("unroll") for (int k = 0; k < 2; ++k) dst[m][k] = *(const LAS bf16x8*)(lds + PG8_SA(b, h) + aoff + m * 2048 + k * 1024); } while (0)
#define PG8_LDB(dst, b, h) do { _Pragma("unroll") for (int n = 0; n < 2; ++n) _Pragma("unroll") for (int k = 0; k < 2; ++k) dst[n][k] = *(const LAS bf16x8*)(lds + PG8_SB(b, h) + boff + n * 2048 + k * 1024); } while (0)
#define PG8_MMA(ai, bj, At, Bt) do { __builtin_amdgcn_s_setprio(1); _Pragma("unroll") for (int m = 0; m < 4; ++m) _Pragma("unroll") for (int n = 0; n < 2; ++n) _Pragma("unroll") for (int k = 0; k < 2; ++k) \
        acc[ai][bj][m][n] = __builtin_amdgcn_mfma_f32_16x16x32_bf16(Bt[n][k], At[m][k], acc[ai][bj][m][n], 0, 0, 0); __builtin_amdgcn_s_setprio(0); } while (0)
#define PG8_WAIT_V(n) asm volatile("s_waitcnt vmcnt(" #n ")" ::: "memory")
#define PG8_WAIT_L(n) asm volatile("s_waitcnt lgkmcnt(" #n ")" ::: "memory")
#define PG8_BAR __builtin_amdgcn_s_barrier()
#define PG8_SCHED __builtin_amdgcn_sched_barrier(0)
    Unit cur, nxt; int ui = 0;
    if (!S.next(0, cur)) return;
    f32x4 acc[2][2][4][2];
#pragma unroll
    for (int a = 0; a < 2; ++a)
#pragma unroll
        for (int b = 0; b < 2; ++b)
#pragma unroll
            for (int m = 0; m < 4; ++m)
#pragma unroll
                for (int n = 0; n < 2; ++n) acc[a][b][m][n] = (f32x4){0.f, 0.f, 0.f, 0.f};
    bf16x8 At[4][2], B0[2][2], B1[2][2];
    LAS float* rsl = (LAS float*)(lds + 131072 + 1024); int cached_pm = -1;
    float rs[2][4];
    const char* cA = (const char*)g.A + (size_t)cur.pm * tstepA; const char* cB = (const char*)g.Bt + (size_t)cur.pn * tstepB;
    PG8_STAGE(PG8_SB(0, 0), cB, voffB); PG8_STAGE(PG8_SB(0, 1), cB + hstepB, voffB); PG8_STAGE(PG8_SA(0, 0), cA, voffA); PG8_STAGE(PG8_SA(0, 1), cA + hstepA, voffA);
    E.pre(cur, wr, fr, tid, rsl, cached_pm, rs);
    if (wr == 1) PG8_BAR;
    PG8_WAIT_V(2); PG8_BAR;
    PG8_STAGE(PG8_SB(1, 0), cB + kstep, voffB); PG8_STAGE(PG8_SA(1, 0), cA + kstep, voffA); PG8_STAGE(PG8_SB(1, 1), cB + hstepB + kstep, voffB);
    PG8_WAIT_V(6); PG8_BAR;
    for (;;) {
        const bool has_next = S.next(ui + 1, nxt);
        const char* nA = has_next ? (const char*)g.A + (size_t)nxt.pm * tstepA : cA; const char* nB = has_next ? (const char*)g.Bt + (size_t)nxt.pn * tstepB : cB;
        for (int t = 0; t < nt; t += 2) {
            const bool last = (t == nt - 2);
            const char* a1 = cA + (size_t)(t + 1) * kstep;
            const char* a2 = last ? nA : cA + (size_t)(t + 2) * kstep; const char* b2 = last ? nB : cB + (size_t)(t + 2) * kstep;
            const char* a3 = a2 + kstep; const char* b3 = b2 + kstep;
            if (t == E.mid_t) E.mid(acc, cur, wr, fr, rsl);
            PG8_LDB(B0, 0, 0); PG8_LDB(B1, 0, 1); PG8_SCHED; PG8_LDA(At, 0, 0); PG8_STAGE(PG8_SA(1, 1), a1 + hstepA, voffA);
            PG8_WAIT_V(8); PG8_WAIT_L(0); PG8_BAR; PG8_MMA(0, 0, At, B0); PG8_MMA(0, 1, At, B1); PG8_BAR; PG8_SCHED;
            PG8_LDA(At, 0, 1); PG8_STAGE(PG8_SB(0, 0), b2, voffB); PG8_STAGE(PG8_SB(0, 1), b2 + hstepB, voffB); PG8_STAGE(PG8_SA(0, 0), a2, voffA);
            PG8_WAIT_V(8); PG8_WAIT_L(0); PG8_BAR; PG8_MMA(1, 0, At, B0); PG8_MMA(1, 1, At, B1); PG8_BAR; PG8_SCHED;
            PG8_LDB(B0, 1, 0); PG8_LDB(B1, 1, 1); PG8_SCHED; PG8_LDA(At, 1, 0); PG8_STAGE(PG8_SA(0, 1), a2 + hstepA, voffA);
            PG8_WAIT_V(8); PG8_WAIT_L(0); PG8_BAR; PG8_MMA(0, 0, At, B0); PG8_MMA(0, 1, At, B1); PG8_BAR; PG8_SCHED;
            PG8_LDA(At, 1, 1); PG8_STAGE(PG8_SB(1, 0), b3, voffB); PG8_STAGE(PG8_SB(1, 1), b3 + hstepB, voffB); PG8_STAGE(PG8_SA(1, 0), a3, voffA);
            PG8_WAIT_V(8); PG8_WAIT_L(0); PG8_BAR; PG8_MMA(1, 0, At, B0); PG8_MMA(1, 1, At, B1); PG8_BAR; PG8_SCHED;
        }
        if (wr == 0) PG8_BAR;
        E(acc, cur, wr, wc, fr, fq, rs);
        if (!has_next) break;
        E.pre(nxt, wr, fr, tid, rsl, cached_pm, rs);
#pragma unroll
        for (int a = 0; a < 2; ++a)
#pragma unroll
            for (int b = 0; b < 2; ++b)
#pragma unroll
                for (int m = 0; m < 4; ++m)
#pragma unroll
                    for (int n = 0; n < 2; ++n) acc[a][b][m][n] = (f32x4){0.f, 0.f, 0.f, 0.f};
        cur = nxt; cA = nA; cB = nB; ++ui;
        if (wr == 1) PG8_BAR;
    }
    PG8_WAIT_V(0);
    PG8_BAR;
#undef PG8_SA
#undef PG8_SB
#undef PG8_STAGE
#undef PG8_LDA
#undef PG8_LDB
#undef PG8_MMA
#undef PG8_WAIT_V
#undef PG8_WAIT_L
#undef PG8_BAR
#undef PG8_SCHED
}
}

namespace att {
constexpr int NW = 8, QBLK = 32, KVBLK = 64, QB = NW * QBLK;
struct CfgMLA { static constexpr int DQK = 192, DV = 128, LDQ = 1792, LDK = 192, LDV = 1792, LDO = 1024, W = SEQ; static constexpr bool SK = false, SINK = false, STAGGER = true, GQA4 = false; static constexpr float SCALE = 0.07216878364870322f; };
struct CfgSWA { static constexpr int DQK = 64, DV = 64, LDQ = INC, LDK = 64, LDV = INC, LDO = 1024, W = 128; static constexpr bool SK = true, SINK = true, STAGGER = false, GQA4 = true; static constexpr float SCALE = 0.125f; };
template <class C> struct Geo {
    static constexpr int KROWB = C::DQK * 2, KCH = (KVBLK * C::DQK / 8) / 512, SHM_K = KVBLK * C::DQK * 2;
    static constexpr int SHM_V = KVBLK * C::DV * 2;
    static constexpr int NKC = C::DQK / 16, NDV = C::DV / 32, VCH = (KVBLK * C::DV / 8) / 512;
    static constexpr int VCB = C::DV / 32;
    static constexpr int LDS_NEED = 2 * SHM_K + 2 * SHM_V + NW * 64 * 4;
};
#define SBAR() __builtin_amdgcn_sched_barrier(0)
__device__ __forceinline__ int crow(int r, int hi) { return (r & 3) + 8 * (r >> 2) + 4 * hi; }
__device__ __forceinline__ bf16x8 ld8(const bf16_t* p) { return *reinterpret_cast<const bf16x8*>(p); }
template <class C> __device__ __forceinline__ int kswz(int row, int colB) { return row * Geo<C>::KROWB + (colB ^ ((row & 7) << 4)); }
template <class C> __device__ __forceinline__ int v_st(int k, int c) { const int kk = (k & ~0xC) | ((k & 4) << 1) | ((k & 8) >> 1); return ((kk >> 3) * Geo<C>::VCB + (c >> 5)) * 512 + ((kk & 7) * 32 + (c & 31)) * 2; }
__device__ __forceinline__ int v_rd_base(int lane) { return ((lane & 3) << 3) | (((lane >> 2) & 3) << 6) | (((lane >> 4) & 1) << 5) | (((lane >> 5) & 1) << 8); }

__device__ __forceinline__ void mask_tile(f32x16& p0, f32x16& p1, int dq, unsigned W) {
    float NEG = -__builtin_inff(); asm volatile("" : "+s"(NEG));
#pragma unroll
    for (int r = 0; r < 16; ++r) {
        const int c = (r & 3) + 8 * (r >> 2);
        if ((unsigned)(dq - c) >= W) p0[r] = NEG;
        if ((unsigned)(dq - c - 32) >= W) p1[r] = NEG;
    }
}
template <class C> __device__ __forceinline__ void partialSM(f32x16& p0, f32x16& p1, float mfix) {
    constexpr float C2 = 1.4426950408889634f * C::SCALE;
    const float mnL = -mfix * C2;
#pragma unroll
    for (int r = 0; r < 16; ++r) p0[r] = fmaf(p0[r], C2, mnL);
#pragma unroll
    for (int r = 0; r < 16; ++r) p1[r] = fmaf(p1[r], C2, mnL);
#pragma unroll
    for (int r = 0; r < 16; ++r) p0[r] = __builtin_amdgcn_exp2f(p0[r]);
}
__device__ __forceinline__ void finishSM(f32x16& p0, f32x16& p1, float& l_reg, bf16x8& pa0, bf16x8& pa1, bf16x8& pa2, bf16x8& pa3) {
#pragma unroll
    for (int r = 0; r < 16; ++r) p1[r] = __builtin_amdgcn_exp2f(p1[r]);
    float ps = 0;
#pragma unroll
    for (int r = 0; r < 16; ++r) ps += p0[r];
#pragma unroll
    for (int r = 0; r < 16; ++r) ps += p1[r];
    { auto rr = __builtin_amdgcn_permlane32_swap(__float_as_uint(ps), __float_as_uint(ps), false, false);
      ps = __uint_as_float(rr[0]) + __uint_as_float(rr[1]); }
    l_reg += ps;
#define PK4(P, B_, OUT) do { unsigned a0 = cvt_pk_bf16(P[B_+0], P[B_+1]), a1 = cvt_pk_bf16(P[B_+2], P[B_+3]);                          \
        unsigned b0 = cvt_pk_bf16(P[B_+4], P[B_+5]), b1 = cvt_pk_bf16(P[B_+6], P[B_+7]);                                             \
        auto r0 = __builtin_amdgcn_permlane32_swap(a0, b0, false, false); auto r1 = __builtin_amdgcn_permlane32_swap(a1, b1, false, false); \
        u32x4 w = {r0[0], r1[0], r0[1], r1[1]}; OUT = *reinterpret_cast<bf16x8*>(&w); } while (0)
    PK4(p0, 0, pa0); PK4(p0, 8, pa1); PK4(p1, 0, pa2); PK4(p1, 8, pa3);
#undef PK4
}
template <int N> __device__ __forceinline__ void wait_lgkm() { asm volatile("s_waitcnt lgkmcnt(%0)" :: "i"(N) : "memory"); }
template <class C, int D> __device__ __forceinline__ void krd(bf16x8& a, bf16x8& b, int kaddr) {
    constexpr int off = (D >> 2) * 128;
    asm volatile("ds_read_b128 %0, %1 offset:%2" : "=&v"(a) : "v"(kaddr), "i"(off) : "memory");
    asm volatile("ds_read_b128 %0, %1 offset:%2" : "=&v"(b) : "v"(kaddr), "i"(off + 32 * Geo<C>::KROWB) : "memory");
}
template <class C, int D> struct QkStep {
    static __device__ __forceinline__ void run(f32x16& p0, f32x16& p1, bf16x8 (&k0r)[3], bf16x8 (&k1r)[3], const int (&ka)[4], const bf16x8* qr) {
        constexpr int NKC = Geo<C>::NKC;
        if constexpr (D + 2 < NKC) krd<C, D + 2>(k0r[(D + 2) % 3], k1r[(D + 2) % 3], ka[(D + 2) & 3]);
        wait_lgkm<(D + 2 < NKC) ? 4 : ((D + 1 < NKC) ? 2 : 0)>(); SBAR();
        p0 = __builtin_amdgcn_mfma_f32_32x32x16_bf16(k0r[D % 3], qr[D], p0, 0, 0, 0);
        p1 = __builtin_amdgcn_mfma_f32_32x32x16_bf16(k1r[D % 3], qr[D], p1, 0, 0, 0); SBAR();
        if constexpr (D + 1 < NKC) QkStep<C, D + 1>::run(p0, p1, k0r, k1r, ka, qr);
    }
};
template <class C>
__device__ __forceinline__ void qkt(f32x16& p0, f32x16& p1, const char* Kbuf, int r32, int hi, const bf16x8* qr, bool act) {
    if (C::SK && !act) { const float NEG = -__builtin_inff();
#pragma unroll
        for (int r = 0; r < 16; ++r) { p0[r] = NEG; p1[r] = NEG; } return; }
    p0 = f32x16{}; p1 = f32x16{};
    const int kbase = (int)(uintptr_t)Kbuf;
    int ka[4];
#pragma unroll
    for (int dd = 0; dd < 4; ++dd) ka[dd] = kbase + kswz<C>(r32, (dd * 16 + hi * 8) * 2);
    bf16x8 k0r[3], k1r[3];
    asm volatile("s_waitcnt lgkmcnt(0)" ::: "memory");
    krd<C, 0>(k0r[0], k1r[0], ka[0]);
    if constexpr (Geo<C>::NKC > 1) krd<C, 1>(k0r[1], k1r[1], ka[1]);
    QkStep<C, 0>::run(p0, p1, k0r, k1r, ka, qr);
}
template <class C>
__device__ __forceinline__ void pv_tile(f32x16* o, int vb0, bf16x8 pa0, bf16x8 pa1, bf16x8 pa2, bf16x8 pa3, bool act) {
    if (C::SK && !act) return;
    constexpr int KS = 2 * Geo<C>::VCB * 512, HF = Geo<C>::VCB * 512, NDV = Geo<C>::NDV;
#define TRRD(dst, off) asm volatile("ds_read_b64_tr_b16 %0, %1 offset:%2" : "=&v"(dst) : "v"(vb0), "i"(off) : "memory")
#define VSET(S_, d) do { constexpr int b_ = (d) * 512; TRRD(S_[0], b_); TRRD(S_[1], b_ + HF); TRRD(S_[2], b_ + KS); TRRD(S_[3], b_ + KS + HF); TRRD(S_[4], b_ + 2 * KS); TRRD(S_[5], b_ + 2 * KS + HF); TRRD(S_[6], b_ + 3 * KS); TRRD(S_[7], b_ + 3 * KS + HF); } while (0)
#define VMMA(S_, d) do { \
        o[d] = __builtin_amdgcn_mfma_f32_32x32x16_bf16(pa0, (bf16x8){S_[0][0], S_[0][1], S_[0][2], S_[0][3], S_[1][0], S_[1][1], S_[1][2], S_[1][3]}, o[d], 0, 0, 0); \
        o[d] = __builtin_amdgcn_mfma_f32_32x32x16_bf16(pa1, (bf16x8){S_[2][0], S_[2][1], S_[2][2], S_[2][3], S_[3][0], S_[3][1], S_[3][2], S_[3][3]}, o[d], 0, 0, 0); \
        o[d] = __builtin_amdgcn_mfma_f32_32x32x16_bf16(pa2, (bf16x8){S_[4][0], S_[4][1], S_[4][2], S_[4][3], S_[5][0], S_[5][1], S_[5][2], S_[5][3]}, o[d], 0, 0, 0); \
        o[d] = __builtin_amdgcn_mfma_f32_32x32x16_bf16(pa3, (bf16x8){S_[6][0], S_[6][1], S_[6][2], S_[6][3], S_[7][0], S_[7][1], S_[7][2], S_[7][3]}, o[d], 0, 0, 0); } while (0)
#define WL8() do { asm volatile("s_waitcnt lgkmcnt(8)" ::: "memory"); SBAR(); } while (0)
#define WL0() do { asm volatile("s_waitcnt lgkmcnt(0)" ::: "memory"); SBAR(); } while (0)
    s16x4 A[8], B[8];
    VSET(A, 0);
    if (NDV == 2) { VSET(B, 1); WL8(); VMMA(A, 0); WL0(); VMMA(B, 1); }
    else { VSET(B, 1); WL8(); VMMA(A, 0); SBAR(); VSET(A, 2); WL8(); VMMA(B, 1); SBAR(); VSET(B, 3); WL8(); VMMA(A, 2); WL0(); VMMA(B, 3); }
#undef TRRD
#undef VSET
#undef VMMA
#undef WL8
#undef WL0
}

struct BlockRef { const bf16_t* Q; const bf16_t* K; const bf16_t* V; bf16_t* O; float* SS; int P0; const float* sinks; };
template <class C> __device__ __forceinline__ void load_q(bf16x8* qr, const bf16_t* qrow, const float* gq, const float* ropep, int hi) {
    constexpr int NKC = Geo<C>::NKC, R0 = (C::DQK - 64) / 16;
    float x[NKC][8]; float ss = 0.f;
#pragma unroll
    for (int d0 = 0; d0 < NKC; ++d0) { const bf16x8 t = ld8(qrow + d0 * 16 + hi * 8);
#pragma unroll
        for (int e = 0; e < 8; ++e) { x[d0][e] = bf2f((bf16_t)t[e]); ss += x[d0][e] * x[d0][e]; } }
    { auto rr = __builtin_amdgcn_permlane32_swap(__float_as_uint(ss), __float_as_uint(ss), false, false); ss = __uint_as_float(rr[0]) + __uint_as_float(rr[1]); }
    const float rstd = rsqrtf(ss * (1.f / C::DQK) + EPS);
#pragma unroll
    for (int d0 = 0; d0 < NKC; ++d0) { const f32x4 g0 = *(const f32x4*)(gq + d0 * 16 + hi * 8), g1 = *(const f32x4*)(gq + d0 * 16 + hi * 8 + 4);
#pragma unroll
        for (int e = 0; e < 4; ++e) { x[d0][e] *= rstd * g0[e]; x[d0][4 + e] *= rstd * g1[e]; } }
#pragma unroll
    for (int k = 0; k < 2; ++k) { const f32x4* rt = (const f32x4*)(ropep + k * 32 + hi * 16);
#pragma unroll
        for (int q = 0; q < 4; ++q) { const f32x4 t = rt[q];
#pragma unroll
            for (int w = 0; w < 2; ++w) { const float c = t[2 * w], sn = t[2 * w + 1], a = x[R0 + k][2 * q + w], b = x[R0 + k + 2][2 * q + w];
                x[R0 + k][2 * q + w] = a * c - b * sn; x[R0 + k + 2][2 * q + w] = b * c + a * sn; } } }
#pragma unroll
    for (int d0 = 0; d0 < NKC; ++d0) { u32x4 w; w.x = cvt_pk_bf16(x[d0][0], x[d0][1]); w.y = cvt_pk_bf16(x[d0][2], x[d0][3]); w.z = cvt_pk_bf16(x[d0][4], x[d0][5]); w.w = cvt_pk_bf16(x[d0][6], x[d0][7]);
        qr[d0] = *reinterpret_cast<bf16x8*>(&w); }
}

__device__ __forceinline__ int swa_jlo(int P0, int W) { const int lowk = P0 - W + 1; return lowk > 0 ? lowk / KVBLK : 0; }

template <class C> __device__ __forceinline__ void dma_v(const bf16_t* Vp, int k0, LAS unsigned char* Vbuf, int tid, int wid) {
#pragma unroll
    for (int i = 0; i < Geo<C>::VCH; ++i) { const int p = tid + 512 * i, sub = p >> 5, q = p & 31, kk = (sub / Geo<C>::VCB) * 8 + (q >> 2), cc = (sub % Geo<C>::VCB) * 32 + (q & 3) * 8;
        const int k = (kk & ~0xC) | ((kk & 4) << 1) | ((kk & 8) >> 1);
        __builtin_amdgcn_global_load_lds((const unsigned*)(Vp + (size_t)(k0 + k) * C::LDV + cc), (LAS unsigned*)(Vbuf + (i * 512 + wid * 64) * 16), 16, 0, 0); }
}
template <class C> __device__ __forceinline__ void dma_k(const bf16_t* Kp, int k0, LAS unsigned char* Kbuf, int tid, int wid) {
#pragma unroll
    for (int i = 0; i < Geo<C>::KCH; ++i) { const int p = tid + 512 * i, row = p / (C::DQK / 8), csw = p % (C::DQK / 8), ch = csw ^ (row & 7);
        __builtin_amdgcn_global_load_lds((const unsigned*)(Kp + (size_t)(k0 + row) * C::LDK + ch * 8), (LAS unsigned*)(Kbuf + (i * 512 + wid * 64) * 16), 16, 0, 0); }
}
#define VMW() asm volatile("s_waitcnt vmcnt(0)" ::: "memory")

template <class C>
__device__ __forceinline__ void attn_block(const BlockRef& cur, char* lds, const float* gq, const float* rope, float mfix, int wv) {
    using G = Geo<C>;
    constexpr int W = C::W, skv = SEQ;
    constexpr bool SK = C::SK;
    const int tid_ = tid_now(wv);
    const int tid = tid_, wid = wv, lane = tid & 63, r32 = lane & 31, hi = lane >> 5;
    const int j_lo = swa_jlo(cur.P0, W);
    constexpr int RQB = C::GQA4 ? 2 * QBLK : QB;
    const int wrow = C::GQA4 ? (wid & 1) * QBLK : wid * QBLK, hs = C::GQA4 ? (wid >> 1) : 0;
    int j_hi = (cur.P0 + RQB - 1) / KVBLK + 1; if (j_hi > skv / KVBLK) j_hi = skv / KVBLK;
    const int NT = j_hi - j_lo;
    const int qlo = cur.P0 + wrow, qm = qlo + r32 - 4 * hi;
    char* V_lds = lds; char* K_lds = lds + 2 * G::SHM_V;
    float* ws = (float*)(lds + 2 * G::SHM_V + 2 * G::SHM_K) + wid * 64; float* li_l = ws, * al_l = ws + 32;
    const float m_reg = mfix; float l_reg = 0; f32x16 o[G::NDV];
#pragma unroll
    for (int d = 0; d < G::NDV; ++d) o[d] = f32x16{};
    const int vb0 = (int)(uintptr_t)V_lds + v_rd_base(lane);
    const bf16_t* Kh = cur.K; const bf16_t* Vh = cur.V;
    bf16x8 qr[G::NKC];
    LAS unsigned char* Vl = (LAS unsigned char*)V_lds; LAS unsigned char* Kl = (LAS unsigned char*)K_lds;
    load_q<C>(qr, cur.Q + hs * C::DQK + (size_t)(wrow + r32) * C::LDQ, gq, rope + (size_t)(cur.P0 + wrow + r32) * 64, hi);
#define KBASE(t) ((j_lo + (t)) * KVBLK)
#define ACT(t) (KBASE(t) <= qlo + QBLK - 1 && KBASE(t) + KVBLK - 1 >= qlo - W + 1)
    dma_k<C>(Kh, KBASE(0), Kl, tid, wid); dma_v<C>(Vh, KBASE(0), Vl, tid, wid); VMW();
    __syncthreads();
    f32x16 p0, p1;
#define WAITB(issued, n) do { if (issued) asm volatile("s_waitcnt vmcnt(%0) lgkmcnt(0)" :: "i"(n) : "memory"); else asm volatile("s_waitcnt vmcnt(0) lgkmcnt(0)" ::: "memory"); __syncthreads(); } while (0)
#define QK(t) do { const bool act_ = ACT(t); SBAR(); qkt<C>(p0, p1, K_lds + ((t) & 1) * G::SHM_K, r32, hi, qr, act_); SBAR();                             \
        { const int kb_ = KBASE(t); if ((!SK || act_) && (kb_ + KVBLK - 1 > qlo || kb_ <= qlo + QBLK - 1 - W)) mask_tile(p0, p1, qm - kb_, (unsigned)W); } \
        partialSM<C>(p0, p1, m_reg); SBAR(); } while (0)
#define SMPV(t) do { bf16x8 pa0, pa1, pa2, pa3; const bool act_ = ACT(t); SBAR();                                                                  \
        finishSM(p0, p1, l_reg, pa0, pa1, pa2, pa3); SBAR();                                                                                       \
        pv_tile<C>(o, vb0 + ((t) & 1) * G::SHM_V, pa0, pa1, pa2, pa3, act_); SBAR(); } while (0)
    if (wid >= 4) __builtin_amdgcn_s_setprio(1);
    if constexpr (!C::STAGGER) {
        for (int t = 0; t < NT; ++t) {
            const bool is = t + 1 < NT;
            if (is) { dma_k<C>(Kh, KBASE(t + 1), Kl + ((t + 1) & 1) * G::SHM_K, tid, wid); dma_v<C>(Vh, KBASE(t + 1), Vl + ((t + 1) & 1) * G::SHM_V, tid, wid); }
            QK(t); SMPV(t); WAITB(false, 0);
        }
    } else if (wid < 4) {
        for (int t = 0; t < NT; ++t) {
            const bool is = t + 1 < NT;
            if (is) dma_k<C>(Kh, KBASE(t + 1), Kl + ((t + 1) & 1) * G::SHM_K, tid, wid);
            QK(t); WAITB(is, G::KCH);
            if (is) dma_v<C>(Vh, KBASE(t + 1), Vl + ((t + 1) & 1) * G::SHM_V, tid, wid);
            SMPV(t); WAITB(is, G::VCH);
        }
        WAITB(false, 0);
    } else {
        { const bool ik = 1 < NT; if (ik) dma_k<C>(Kh, KBASE(1), Kl + G::SHM_K, tid, wid); WAITB(ik, G::KCH); }
        for (int t = 0; t < NT; ++t) {
            const bool iv = t + 1 < NT, ik = t + 2 < NT;
            if (iv) dma_v<C>(Vh, KBASE(t + 1), Vl + ((t + 1) & 1) * G::SHM_V, tid, wid);
            QK(t); WAITB(iv, G::VCH);
            if (ik) dma_k<C>(Kh, KBASE(t + 2), Kl + (t & 1) * G::SHM_K, tid, wid);
            SMPV(t); WAITB(ik, G::KCH);
        }
    }
    __builtin_amdgcn_s_setprio(0);
#undef WAITB
#undef QK
#undef SMPV
    if (C::SINK) l_reg += __builtin_amdgcn_exp2f(cur.sinks[hs] * 1.4426950408889634f - m_reg * (1.4426950408889634f * C::SCALE));
    if (hi == 0) li_l[r32] = l_reg; asm volatile("s_waitcnt lgkmcnt(0)" ::: "memory");
    int hi_e = hi, r32_e = r32; asm volatile("" : "+v"(hi_e), "+v"(r32_e));
    bf16_t* Ow = cur.O + hs * C::DV + (size_t)(wrow + 4 * hi_e) * C::LDO + r32_e;
    float* SSw = cur.SS + hs + (size_t)(wrow + 4 * hi_e) * 16;
#pragma unroll
    for (int r = 0; r < 16; ++r) { const int orow0 = (r & 3) + 8 * (r >> 2); float sq = 0.f; const float rl = __builtin_amdgcn_rcpf(li_l[crow(r, hi)]);
#pragma unroll
        for (int d0 = 0; d0 < G::NDV; ++d0) { const float v = o[d0][r] * rl; sq += v * v;
            const float vn = shx<1>(v);
            if ((r32 & 1) == 0) *(unsigned*)(Ow + orow0 * C::LDO + d0 * 32) = cvt_pk_bf16(v, vn); }
        sq += shx<1>(sq); sq += shx<2>(sq); sq += shx<4>(sq); sq += shx<8>(sq); sq += shx<16>(sq);
        if (r32 == 0) SSw[orow0 * 16] = sq; }
    __syncthreads();
#undef KBASE
#undef ACT
}

__device__ __forceinline__ int swa_nramp(int nqb, int W) { const int t = W - 1; const int n = t < 0 ? 0 : t / QB + 1; return n > nqb ? nqb : n; }
struct Item { int bh, qb0, qb1; };
__device__ __forceinline__ Item decode(int L, int nqb, int nx, int nramp) {
    Item it; it.bh = L / nx; const int x = L - it.bh * nx; const int ns = nqb - nramp;
    if (x < ns) { it.qb0 = it.qb1 = nqb - 1 - x; } else { it.qb0 = x - ns; it.qb1 = nramp - 1 - it.qb0; }
    return it;
}
struct Tensors { const bf16_t* qakv; const bf16_t* km; const bf16_t* p; const bf16_t* ks; bf16_t* mix; float* oss; const float* sinks; const float* gq_mla; const float* gq_swa; const float* gk_mla; const float* gk_swa; const float* rope; };
template <class C> __device__ __forceinline__ BlockRef make_ref(const Tensors& T, const Item& it, int pass) {
    const int qb = pass ? it.qb1 : it.qb0; BlockRef r; r.sinks = T.sinks;
    if (!C::SINK) {
        r.P0 = qb * QB;
        const int b = it.bh >> 2, h = it.bh & 3; const size_t m0 = (size_t)b * SEQ;
        r.Q = T.qakv + (m0 + r.P0) * 1792 + h * 192; r.K = T.km + (size_t)it.bh * SEQ * 192; r.V = T.qakv + m0 * 1792 + 768 + h * 256 + 128;
        r.O = T.mix + (m0 + r.P0) * 1024 + h * 128; r.SS = T.oss + (m0 + r.P0) * 16 + h;
    } else {
        r.P0 = qb * 2 * QBLK;
        const int b = it.bh >> 1, kvh = it.bh & 1; const size_t m0 = (size_t)b * SEQ;
        r.Q = T.p + (m0 + r.P0) * INC + 448 + kvh * 256; r.K = T.ks + (size_t)it.bh * SEQ * 64; r.V = T.p + m0 * INC + 1088 + kvh * 64;
        r.O = T.mix + (m0 + r.P0) * 1024 + 512 + kvh * 256; r.SS = T.oss + (m0 + r.P0) * 16 + 8 + kvh * 4;
        r.sinks = T.sinks + kvh * 4;
    }
    return r;
}
template <class C> __device__ __forceinline__ void attn_phase(char* lds, const Tensors& T, int nbh, int G_, int c_, int wv) {
    float mfix;
    { const float* gq = C::SINK ? T.gq_swa : T.gq_mla; const float* gk = C::SINK ? T.gk_swa : T.gk_mla; const int ln = lane_id_v(); float mq = 0.f, mk = 0.f;
      for (int i = ln; i < C::DQK; i += 64) { mq = fmaxf(mq, fabsf(gq[i])); mk = fmaxf(mk, fabsf(gk[i])); }
      mq = fmaxf(mq, shx<1>(mq)); mq = fmaxf(mq, shx<2>(mq)); mq = fmaxf(mq, shx<4>(mq)); mq = fmaxf(mq, shx<8>(mq)); mq = fmaxf(mq, shx<16>(mq));
      mk = fmaxf(mk, shx<1>(mk)); mk = fmaxf(mk, shx<2>(mk)); mk = fmaxf(mk, shx<4>(mk)); mk = fmaxf(mk, shx<8>(mk)); mk = fmaxf(mk, shx<16>(mk));
      { auto r1 = __builtin_amdgcn_permlane32_swap(__float_as_uint(mq), __float_as_uint(mq), false, false); mq = fmaxf(__uint_as_float(r1[0]), __uint_as_float(r1[1]));
        auto r2 = __builtin_amdgcn_permlane32_swap(__float_as_uint(mk), __float_as_uint(mk), false, false); mk = fmaxf(__uint_as_float(r2[0]), __uint_as_float(r2[1])); }
      mfix = (float)C::DQK * mq * mk * 1.0001f; mfix = __uint_as_float(__builtin_amdgcn_readfirstlane(__float_as_uint(mfix))); }
    const int nqb = C::GQA4 ? SEQ / (2 * QBLK) : SEQ / QB, nramp = C::GQA4 ? 0 : swa_nramp(nqb, C::W), nx = (nramp + 1) / 2 + (nqb - nramp), total = nx * nbh;
    const int cv = (G_ % 8 == 0) ? (c_ % 8) * (G_ / 8) + c_ / 8 : c_;
    for (int L = cv; L < total; L += G_) {
        const Item it = decode(L, nqb, nx, nramp);
        const int np = it.qb1 != it.qb0 ? 2 : 1;
        for (int pass = 0; pass < np; ++pass) { const BlockRef cur = make_ref<C>(T, it, pass); attn_block<C>(cur, lds, C::SINK ? T.gq_swa : T.gq_mla, T.rope, mfix, wv); }
    }
}
}

#define XB_TMO      128
#define XB_XCNT(j)  (256  + 64 * (j))
#define XB_XSUB(j)  (1280 + 64 * (j))
#define XB_XGEN(j)  (2304 + 64 * (j))
#define XB_TOP      3328
#define XB_TOPGEN   3392
#define XCD_BAR_WORDS 3456
#define XB_SPIN_CAP (1u << 18)
__device__ __forceinline__ unsigned xb_ld(unsigned* p)              { return __hip_atomic_load(p, __ATOMIC_RELAXED, __HIP_MEMORY_SCOPE_AGENT); }
__device__ __forceinline__ unsigned xb_add(unsigned* p, unsigned v) { return __hip_atomic_fetch_add(p, v, __ATOMIC_RELAXED, __HIP_MEMORY_SCOPE_AGENT); }
__device__ __forceinline__ unsigned xb_xcc_id() { return (unsigned)__builtin_amdgcn_s_getreg((3 << 11) | 20) & 0xFu; }
#define XB_SPIN(cond, bar) do { unsigned _sp = 0; while (cond) { __builtin_amdgcn_s_sleep(1); \
    if ((++_sp & 255u) == 0u) { if (xb_ld(&(bar)[XB_TMO])) break; if (_sp > XB_SPIN_CAP) { atomicAdd(&(bar)[XB_TMO], 1u); break; } } } } while (0)
struct XcdBarrier { unsigned* bar; unsigned x; volatile LAS unsigned* st; };
__device__ __forceinline__ XcdBarrier xcd_barrier_post(unsigned* bar, volatile LAS unsigned* st) {
    XcdBarrier b; b.bar = bar; b.x = xb_xcc_id(); b.st = st;
    if (threadIdx.x == 0) (void)xb_add(&bar[XB_XCNT(b.x)], 1u);
    return b;
}
__device__ __forceinline__ void xcd_barrier_complete(unsigned* bar, unsigned x, unsigned& nloc, unsigned& nx) {
    const unsigned G = gridDim.x * gridDim.y * gridDim.z;
    unsigned sum, cnt, mine, sp = 0u;
    for (;;) {
        sum = 0u; cnt = 0u; mine = 0u;
#pragma unroll
        for (unsigned j = 0; j < 16; ++j) { const unsigned c = xb_ld(&bar[XB_XCNT(j)]); sum += c; cnt += (c > 0u) ? 1u : 0u; mine = (j == x) ? c : mine; }
        if (sum == G) break;
        __builtin_amdgcn_s_sleep(1);
        if ((++sp & 255u) == 0u) { if (xb_ld(&bar[XB_TMO])) break; if (sp > XB_SPIN_CAP) { atomicAdd(&bar[XB_TMO], 1u); break; } }
    }
    nloc = mine > 0u ? mine : 1u; nx = cnt > 0u ? cnt : 1u;
}
__device__ __forceinline__ void xcd_barrier(const XcdBarrier& b, int wv) {
    asm volatile("s_waitcnt vmcnt(0)" ::: "memory");
    __syncthreads();
    if (wv == 0 && lane_id_v() == 0) {
        unsigned* bar = b.bar;
        __builtin_amdgcn_s_waitcnt(0);
        unsigned nloc = b.st[0], nx = b.st[1];
        if (nloc == 0u) { xcd_barrier_complete(bar, b.x, nloc, nx); b.st[0] = nloc; b.st[1] = nx; }
        const unsigned old = xb_add(&bar[XB_XSUB(b.x)], 1u);
        const unsigned gen = old / nloc;
        if (old + 1u == (gen + 1u) * nloc) {
            __builtin_amdgcn_fence(__ATOMIC_RELEASE, "agent");
            asm volatile("s_waitcnt vmcnt(0)" ::: "memory");
            const unsigned og = xb_add(&bar[XB_TOP], 1u);
            const unsigned tg = og / nx;
            if (og + 1u == (tg + 1u) * nx) xb_add(&bar[XB_TOPGEN], 1u);
            else XB_SPIN(xb_ld(&bar[XB_TOPGEN]) == tg, bar);
            __builtin_amdgcn_fence(__ATOMIC_ACQUIRE, "agent");
            xb_add(&bar[XB_XGEN(b.x)], 1u);
            asm volatile("s_waitcnt vmcnt(0)" ::: "memory");
        } else {
            XB_SPIN(xb_ld(&bar[XB_XGEN(b.x)]) == gen, bar);
            __builtin_amdgcn_fence(__ATOMIC_ACQUIRE, "agent");
            asm volatile("s_waitcnt vmcnt(0)" ::: "memory");
        }
    }
    __syncthreads();
}

struct Params { const float* in[23]; float* out; unsigned char* ws; int ph_lo, ph_hi; };

struct TJob { const float* W; const float* gain; bf16_t* WT; int K, N, ldt, coloff, rmap; };
struct TrIn { f32x4 wv[8]; float gs[8]; };
__device__ __forceinline__ void tr_load(const TJob& J, int item, int lane, TrIn& T) {
    const int nblk = J.N / 32, kb = item / nblk, nb = item % nblk, k0 = 64 * kb, n0 = 32 * nb;
#pragma unroll
    for (int i = 0; i < 8; ++i) { const int kk = 8 * i + (lane >> 3); T.wv[i] = *(const f32x4*)(J.W + (size_t)(k0 + kk) * J.N + n0 + (lane & 7) * 4); T.gs[i] = J.gain ? J.gain[k0 + kk] : 1.f; }
}
__device__ __forceinline__ void tr_proc(const TJob& J, LAS float* scr, int item, int lane, const TrIn& T) {
    const int nblk = J.N / 32, kb = item / nblk, nb = item % nblk, k0 = 64 * kb, n0 = 32 * nb;
#pragma unroll
    for (int i = 0; i < 8; ++i) { const int kk = 8 * i + (lane >> 3); LAS float* d = scr + kk * 33 + (lane & 7) * 4;
        d[0] = T.wv[i][0] * T.gs[i]; d[1] = T.wv[i][1] * T.gs[i]; d[2] = T.wv[i][2] * T.gs[i]; d[3] = T.wv[i][3] * T.gs[i]; }
    asm volatile("s_waitcnt lgkmcnt(0)" ::: "memory");
    const int c = lane & 7;
    int rb = n0;
    if (J.rmap) rb = 256 * (n0 >> 7) + (n0 & 127) + (J.rmap == 2 ? 128 : 0);
#pragma unroll
    for (int j = 0; j < 4; ++j) { const int n = (lane >> 3) + 8 * j; const LAS float* s = scr + (8 * c) * 33 + n;
        u32x4 o; o.x = cvt_pk_bf16(s[0 * 33], s[1 * 33]); o.y = cvt_pk_bf16(s[2 * 33], s[3 * 33]); o.z = cvt_pk_bf16(s[4 * 33], s[5 * 33]); o.w = cvt_pk_bf16(s[6 * 33], s[7 * 33]);
        *(u32x4*)(J.WT + (size_t)(rb + n) * J.ldt + J.coloff + k0 + 8 * c) = o; }
    asm volatile("s_waitcnt lgkmcnt(0)" ::: "memory");
}
__device__ __forceinline__ TJob get_job(const Params& P, int l, int j) {
    unsigned char* wl = P.ws + WS_W + (size_t)l * W_LAYER; TJob J; J.coloff = 0; J.rmap = 0;
    switch (j) {
    case 0: J.W = P.in[2] + (size_t)l * DM * DFF; J.gain = P.in[1] + l * DM; J.WT = (bf16_t*)(wl + OW_1T); J.K = DM; J.N = DFF; J.ldt = DM; J.rmap = 1; break;
    case 1: J.W = P.in[3] + (size_t)l * DM * DFF; J.gain = P.in[1] + l * DM; J.WT = (bf16_t*)(wl + OW_1T); J.K = DM; J.N = DFF; J.ldt = DM; J.rmap = 2; break;
    case 2: J.W = P.in[4] + (size_t)l * DFF * DM; J.gain = nullptr; J.WT = (bf16_t*)(wl + OW_1D); J.K = DFF; J.N = DM; J.ldt = DFF; break;
    case 3: J.W = P.in[20] + (size_t)l * DM * DFF; J.gain = P.in[19] + l * DM; J.WT = (bf16_t*)(wl + OW_2T); J.K = DM; J.N = DFF; J.ldt = DM; J.rmap = 1; break;
    case 4: J.W = P.in[21] + (size_t)l * DM * DFF; J.gain = P.in[19] + l * DM; J.WT = (bf16_t*)(wl + OW_2T); J.K = DM; J.N = DFF; J.ldt = DM; J.rmap = 2; break;
    case 5: J.W = P.in[22] + (size_t)l * DFF * DM; J.gain = nullptr; J.WT = (bf16_t*)(wl + OW_2D); J.K = DFF; J.N = DM; J.ldt = DFF; break;
    case 6: J.W = P.in[6] + (size_t)l * DM * INC; J.gain = P.in[5] + l * DM; J.WT = (bf16_t*)(wl + OW_IN); J.K = DM; J.N = INC; J.ldt = DM; break;
    case 7: J.W = P.in[8] + (size_t)l * 256 * 768; J.gain = P.in[7] + l * 256; J.WT = (bf16_t*)(wl + OW_QB); J.K = 256; J.N = 768; J.ldt = 256; break;
    case 8: J.W = P.in[10] + (size_t)l * 128 * 1024; J.gain = P.in[9] + l * 128; J.WT = (bf16_t*)(wl + OW_KVB); J.K = 128; J.N = 1024; J.ldt = 128; break;
    case 9: J.W = P.in[18] + (size_t)l * DM * DM; J.gain = P.in[16] + l * 512; J.WT = (bf16_t*)(wl + OW_O); J.K = 512; J.N = DM; J.ldt = DM; break;
    default: J.W = P.in[18] + (size_t)l * DM * DM + (size_t)512 * DM; J.gain = P.in[17] + l * 512; J.WT = (bf16_t*)(wl + OW_O); J.K = 512; J.N = DM; J.ldt = DM; J.coloff = 512; break;
    }
    return J;
}
__device__ __forceinline__ void prologue(const Params& P, LAS unsigned char* lds, int G, int wv) {
    const int lane = lane_id_v(), wave = wv;
    LAS float* scr = (LAS float*)(lds + wave * 16384);
    const int gw = blockIdx.x * NWAVES + wave, NGW = G * NWAVES;
    int rot = 0;
    TrIn cur; TJob Jc = get_job(P, 0, 0); int itc = 0; bool have = false;
    for (int l = 0; l < DEPTH; ++l)
        for (int j = 0; j < 11; ++j) {
            const TJob J = get_job(P, l, j);
            const int nit = (J.K / 64) * (J.N / 32);
            int first = gw - rot; if (first < 0) first += NGW;
#ifndef NO_TR
            for (int it = first; it < nit; it += NGW) {
                TrIn nx; tr_load(J, it, lane, nx);
                if (have) tr_proc(Jc, scr, itc, lane, cur);
                cur = nx; Jc = J; itc = it; have = true;
            }
#endif
            rot = (rot + nit) % NGW;
        }
    if (have) tr_proc(Jc, scr, itc, lane, cur);
    const float* x = P.in[0]; bf16_t* xb = (bf16_t*)(P.ws + WS_XB); float* xss = (float*)(P.ws + WS_XSS);
#ifndef NO_XB
    for (int m = gw; m < MTOK; m += 2 * NGW) {
        const int m2 = (m + NGW < MTOK) ? m + NGW : m;
        const f32x4* xr = (const f32x4*)(x + (size_t)m * DM) + lane; const f32x4* xr2 = (const f32x4*)(x + (size_t)m2 * DM) + lane; f32x4 v[4], v2[4]; float s = 0.f, s2 = 0.f;
#pragma unroll
        for (int j = 0; j < 4; ++j) v[j] = xr[64 * j];
#pragma unroll
        for (int j = 0; j < 4; ++j) v2[j] = xr2[64 * j];
#pragma unroll
        for (int j = 0; j < 4; ++j) { s += (v[j][0] * v[j][0] + v[j][1] * v[j][1]) + (v[j][2] * v[j][2] + v[j][3] * v[j][3]); s2 += (v2[j][0] * v2[j][0] + v2[j][1] * v2[j][1]) + (v2[j][2] * v2[j][2] + v2[j][3] * v2[j][3]); }
        s = wave_sum(s); s2 = wave_sum(s2);
        unsigned long long* o8 = (unsigned long long*)(xb + (size_t)m * DM) + lane; unsigned long long* o82 = (unsigned long long*)(xb + (size_t)m2 * DM) + lane;
#pragma unroll
        for (int j = 0; j < 4; ++j) o8[64 * j] = (unsigned long long)cvt_pk_bf16(v[j][0], v[j][1]) | ((unsigned long long)cvt_pk_bf16(v[j][2], v[j][3]) << 32);
        if (lane < 16) xss[(size_t)m * 16 + lane] = lane == 0 ? s : 0.f;
        if (m2 != m) {
#pragma unroll
            for (int j = 0; j < 4; ++j) o82[64 * j] = (unsigned long long)cvt_pk_bf16(v2[j][0], v2[j][1]) | ((unsigned long long)cvt_pk_bf16(v2[j][2], v2[j][3]) << 32);
            if (lane < 16) xss[(size_t)m2 * 16 + lane] = lane == 0 ? s2 : 0.f;
        }
    }
#endif
    { float2* rope = (float2*)(P.ws + WS_ROPE);
      for (int e = gw * 64 + lane; e < SEQ * 32; e += NGW * 64) { const int pos = e >> 5, i = e & 31;
          const float inv = 1.0f / powf(10000.0f, (float)(2 * i) / 64.0f); const float ang = (float)pos * inv;
          rope[e] = make_float2(cosf(ang), sinf(ang)); } }
}

__device__ __forceinline__ void ld8f(const bf16_t* p, float (&v)[8]) {
    const bf16x8 t = *reinterpret_cast<const bf16x8*>(p);
#pragma unroll
    for (int e = 0; e < 8; ++e) v[e] = bf2f((bf16_t)t[e]);
}
__device__ __forceinline__ void st8f(bf16_t* p, const float (&v)[8]) {
    u32x4 w; w.x = cvt_pk_bf16(v[0], v[1]); w.y = cvt_pk_bf16(v[2], v[3]); w.z = cvt_pk_bf16(v[4], v[5]); w.w = cvt_pk_bf16(v[6], v[7]);
    *(u32x4*)p = w;
}
__device__ __forceinline__ float ssq8(const float (&v)[8]) { return ((v[0] * v[0] + v[1] * v[1]) + (v[2] * v[2] + v[3] * v[3])) + ((v[4] * v[4] + v[5] * v[5]) + (v[6] * v[6] + v[7] * v[7])); }
__device__ __forceinline__ float bperm(float v, int src_lane) { return __uint_as_float((unsigned)__builtin_amdgcn_ds_bpermute(src_lane << 2, (int)__float_as_uint(v))); }
__device__ __forceinline__ float red8(float s) { s += shx<1>(s); s += shx<2>(s); s += shx<4>(s); return s; }
__device__ __forceinline__ void norm_rope(float (&v)[8], float rstd, const float (&g)[8], bool rope, const float (&cs)[8], const float (&sn)[8]) {
#pragma unroll
    for (int e = 0; e < 8; ++e) { v[e] *= rstd * g[e]; const float pr = shx<4>(v[e]); const float r = v[e] * cs[e] + pr * sn[e]; v[e] = rope ? r : v[e]; }
}
__device__ __forceinline__ void prep_phase(const Params& P, int l, int G, int wv) {
    const int lane = lane_id_v(), wave = wv;
    const int gw = blockIdx.x * NWAVES + wave, NGW = G * NWAVES;
    bf16_t* qakv = (bf16_t*)(P.ws + WS_QAKV); const bf16_t* pb = (const bf16_t*)(P.ws + WS_P);
    bf16_t* km = (bf16_t*)(P.ws + WS_KM); bf16_t* qs = (bf16_t*)(P.ws + WS_QS); bf16_t* ks = (bf16_t*)(P.ws + WS_KS);
    const float* rope = (const float*)(P.ws + WS_ROPE);
    const int hsub = lane / 24, c = lane - hsub * 24, c8 = lane & 7;
    const bool mact = lane < 48, mrope = c >= 16; const int hb = (hsub > 1 ? 1 : hsub) * 24;
    float gq[8], gk[8], gsq[8], gsk[8];
#pragma unroll
    for (int e = 0; e < 8; ++e) { gq[e] = P.in[11][l * 192 + c * 8 + e]; gk[e] = P.in[12][l * 192 + c * 8 + e]; gsq[e] = P.in[13][l * 64 + c8 * 8 + e]; gsk[e] = P.in[14][l * 64 + c8 * 8 + e]; }
    const float sgn = (c8 & 4) ? 1.f : -1.f;
    struct TokIn { f32x4 rt[4]; bf16x8 kp[2]; bf16x8 sk; };
    const int hs_ = hsub > 1 ? 1 : hsub;
#define LOADTOK(T_, m_) do { const int s_ = (m_) % SEQ; const f32x4* rt_ = (const f32x4*)(rope + (size_t)s_ * 64 + (c8 & 3) * 16);                          \
        _Pragma("unroll") for (int q = 0; q < 4; ++q) T_.rt[q] = rt_[q];                                                                                    \
        const bf16_t* qrow_ = qakv + (size_t)(m_) * 1792; const bf16_t* prow_ = pb + (size_t)(m_) * INC;                                                   \
        _Pragma("unroll") for (int p = 0; p < 2; ++p) T_.kp[p] = *reinterpret_cast<const bf16x8*>(mrope ? prow_ + 384 + (c - 16) * 8 : qrow_ + 768 + (2 * p + hs_) * 256 + c * 8); \
        T_.sk = *reinterpret_cast<const bf16x8*>(prow_ + 960 + (lane & 15) * 8); } while (0)
#define PROCTOK(T_, m_) do { const int b = (m_) / SEQ, s = (m_) % SEQ; float cs[8], sn[8];                                                                    \
        _Pragma("unroll") for (int q = 0; q < 4; ++q) { const f32x4 t = T_.rt[q]; cs[2 * q] = t[0]; sn[2 * q] = t[1] * sgn; cs[2 * q + 1] = t[2]; sn[2 * q + 1] = t[3] * sgn; } \
        _Pragma("unroll") for (int p = 0; p < 2; ++p) { const int h = 2 * p + hs_; float v[8];                                                                \
            _Pragma("unroll") for (int e = 0; e < 8; ++e) v[e] = bf2f((bf16_t)T_.kp[p][e]);                                                                \
            { const float t = red8(ssq8(v)); const float tot = bperm(t, hb) + bperm(t, hb + 8) + bperm(t, hb + 16);                                         \
              norm_rope(v, rsqrtf(tot * (1.f / 192.f) + EPS), gk, mrope, cs, sn); }                                                                          \
            if (mact) st8f(km + ((size_t)(b * 4 + h) * SEQ + s) * 192 + c * 8, v); }                                                                         \
        { float v[8]; const int lk = lane & 15;                                                                                                              \
          _Pragma("unroll") for (int e = 0; e < 8; ++e) v[e] = bf2f((bf16_t)T_.sk[e]);                                                                      \
          norm_rope(v, rsqrtf(red8(ssq8(v)) * (1.f / 64.f) + EPS), gsk, true, cs, sn);                                                                       \
          if (lane < 16) st8f(ks + ((size_t)(b * 2 + (lk >> 3)) * SEQ + s) * 64 + c8 * 8, v); } } while (0)
    for (int m = gw; m < MTOK; m += 4 * NGW) {
        TokIn A, B, C_, D_; const int m2 = m + NGW, m3 = m + 2 * NGW, m4 = m + 3 * NGW; const bool h2 = m2 < MTOK, h3 = m3 < MTOK, h4 = m4 < MTOK;
        LOADTOK(A, m); LOADTOK(B, (h2 ? m2 : m)); LOADTOK(C_, (h3 ? m3 : m)); LOADTOK(D_, (h4 ? m4 : m));
        PROCTOK(A, m);
        if (h2) PROCTOK(B, m2);
        if (h3) PROCTOK(C_, m3);
        if (h4) PROCTOK(D_, m4);
    }
#undef LOADTOK
#undef PROCTOK
}

constexpr int NPH = 1 + 9 * DEPTH;
__device__ __forceinline__ int gemm_count(int k) { return (k == 3) ? 2 : ((k == 4 || k == 5) ? 0 : 1); }
__device__ __forceinline__ void make_gemm(const Params& P, int l, int k, int gi, pg8::Gemm& g, pg8::Epi& E) {
    unsigned char* ws = P.ws; unsigned char* wl = ws + WS_W + (size_t)l * W_LAYER;
    bf16_t* xb = (bf16_t*)(ws + WS_XB); bf16_t* act = (bf16_t*)(ws + WS_ACT); bf16_t* pb = (bf16_t*)(ws + WS_P); bf16_t* qakv = (bf16_t*)(ws + WS_QAKV); bf16_t* mix = (bf16_t*)(ws + WS_MIX);
    float* xss = (float*)(ws + WS_XSS); float* css = (float*)(ws + WS_CSS); float* oss = (float*)(ws + WS_OSS);
    g.M = MTOK; E.stats = nullptr; E.np4 = 0; E.inv_n = 0.f; E.alpha = 1.f; E.res = nullptr; E.outf = nullptr; E.outb = nullptr; E.ldc = 0; E.ncols = 1 << 30; E.ssq = nullptr; E.wb = 0; E.mstats = nullptr; E.mid_t = -1;
    if (k == 0 || k == 7) {
        g.A = xb; g.lda = DM; g.Bt = (const bf16_t*)(wl + (k == 0 ? OW_1T : OW_2T)); g.ldb = DM; g.N = 2 * DFF; g.K = DM;
        E.mode = pg8::MODE_SWIGLU; E.stats = xss; E.np4 = 4; E.inv_n = 1.f / DM; E.outb = act; E.ldc = DFF;
    } else if (k == 1 || k == 8) {
        g.A = act; g.lda = DFF; g.Bt = (const bf16_t*)(wl + (k == 1 ? OW_1D : OW_2D)); g.ldb = DFF; g.N = DM; g.K = DFF;
        E.mode = pg8::MODE_RESID; E.alpha = 0.5f; E.res = (l == 0 && k == 1) ? P.in[0] : nullptr; E.outf = (l == DEPTH - 1 && k == 8) ? P.out : nullptr; E.outb = xb; E.ldc = DM; E.ssq = xss; E.wb = 1;
    } else if (k == 2) {
        g.A = xb; g.lda = DM; g.Bt = (const bf16_t*)(wl + OW_IN); g.ldb = DM; g.N = 1280; g.K = DM;
        E.mode = pg8::MODE_SCALE; E.stats = xss; E.np4 = 4; E.inv_n = 1.f / DM; E.outb = pb; E.ldc = INC; E.ncols = INC; E.ssq = css;
    } else if (k == 3) {
        E.mode = pg8::MODE_SCALE; E.np4 = 1; E.ldc = 1792;
        if (gi == 0) { g.A = pb; g.lda = INC; g.Bt = (const bf16_t*)(wl + OW_QB); g.ldb = 256; g.N = 768; g.K = 256; E.stats = css; E.inv_n = 1.f / 256.f; E.outb = qakv; }
        else { g.A = pb + 256; g.lda = INC; g.Bt = (const bf16_t*)(wl + OW_KVB); g.ldb = 128; g.N = 1024; g.K = 128; E.stats = css + 4; E.inv_n = 1.f / 128.f; E.outb = qakv + 768; }
    } else {
        E.mode = pg8::MODE_RESID; E.outb = xb; E.ssq = xss; E.wb = 1; E.ldc = DM; E.inv_n = 1.f / 512.f; E.stats = oss + 8; E.np4 = 2; E.mstats = oss; E.mid_t = 8;
        g.A = mix; g.lda = DM; g.Bt = (const bf16_t*)(wl + OW_O); g.ldb = DM; g.N = DM; g.K = DM;
    }
}

__global__ void __launch_bounds__(NTHR, 2) fwd_megakernel(Params P) {
    extern __shared__ __attribute__((aligned(16))) unsigned char lds[];
    cg::grid_group grid = cg::this_grid();
    const int G = gridDim.x;
    LAS unsigned char* ldsl = (LAS unsigned char*)lds;
    volatile LAS unsigned* bst = (volatile LAS unsigned*)(ldsl + 131072 + 512);
    const int wv = __builtin_amdgcn_readfirstlane((int)threadIdx.x >> 6);
    if (threadIdx.x < 2) bst[threadIdx.x] = 0u;
    __syncthreads();
    XcdBarrier xbar; xbar.bar = (unsigned*)(P.ws + WS_CTL); xbar.x = 0; xbar.st = bst;
    const bool coop = (P.ph_hi - P.ph_lo) > 1;
    if (coop) xbar = xcd_barrier_post((unsigned*)(P.ws + WS_CTL), bst);
    if (P.ph_lo < 0) grid.sync();
    int ph0 = P.ph_lo;
    if (ph0 == 0) {
        prologue(P, ldsl, G, wv);
        if (1 < P.ph_hi) xcd_barrier(xbar, wv);
        ph0 = 1;
    }
    for (int ph = ph0; ph < P.ph_hi; ++ph) {
        {
            const int l = (ph - 1) / 9, k = (ph - 1) % 9;
            if (k == 4) {
#ifndef NO_PREP
                prep_phase(P, l, G, wv);
#endif
            } else if (k == 5) {
                att::Tensors T; T.qakv = (const bf16_t*)(P.ws + WS_QAKV); T.km = (const bf16_t*)(P.ws + WS_KM); T.p = (const bf16_t*)(P.ws + WS_P);
                T.ks = (const bf16_t*)(P.ws + WS_KS); T.gq_mla = P.in[11] + l * 192; T.gq_swa = P.in[13] + l * 64; T.gk_mla = P.in[12] + l * 192; T.gk_swa = P.in[14] + l * 64; T.rope = (const float*)(P.ws + WS_ROPE); T.mix = (bf16_t*)(P.ws + WS_MIX); T.oss = (float*)(P.ws + WS_OSS); T.sinks = P.in[15] + l * 8;
#ifndef REP_MLA
#define REP_MLA 1
#endif
#ifndef REP_SWA
#define REP_SWA 1
#endif
#ifndef REP_K
#define REP_K -1
#endif
                for (int rep = 0; rep < REP_MLA; ++rep) att::attn_phase<att::CfgMLA>((char*)lds, T, BATCH * 4, G, (int)blockIdx.x, wv);
                for (int rep = 0; rep < REP_SWA; ++rep) att::attn_phase<att::CfgSWA>((char*)lds, T, BATCH * 2, G, (int)blockIdx.x, wv);
            } else {
                const int ng = gemm_count(k);
                const int nrep = ((k == REP_K) || (REP_K == 0 && k == 7)) ? 2 : 1;
                for (int gi = 0; gi < ng * nrep; ++gi) {
                    pg8::Gemm g; pg8::Epi E; make_gemm(P, l, k, gi % ng, g, E);
                    pg8::StaticOrder S; S.init(g.M, g.N, G, (int)blockIdx.x);
#ifndef NO_GEMM
                    pg8::gemm_phase(ldsl, g, S, E, wv);
#endif
                }
            }
        }
        if (ph + 1 < P.ph_hi) xcd_barrier(xbar, wv);
    }
}

#ifndef MK_SPLIT
#define MK_SPLIT 0
#endif
extern "C" void kernel_launch(void* const* d_in, const int* in_sizes, int n_in, void* d_out, int out_size, void* d_ws, size_t ws_size, hipStream_t stream) {
    static int grid = 0;
    if (grid == 0) {
        if (n_in != 23 || out_size != MTOK * DM || ws_size < WS_END) { fprintf(stderr, "kernel_launch: unexpected shapes: n_in %d out %d ws %zu (need %zu)\n", n_in, out_size, ws_size, (size_t)WS_END); grid = -1; return; }
        int dev = 0, cus = 0, per_cu = 0;
        (void)hipGetDevice(&dev); (void)hipDeviceGetAttribute(&cus, hipDeviceAttributeMultiprocessorCount, dev);
        if (hipFuncSetAttribute((const void*)fwd_megakernel, hipFuncAttributeMaxDynamicSharedMemorySize, LDS_BYTES) != hipSuccess) { fprintf(stderr, "kernel_launch: hipFuncSetAttribute failed\n"); grid = -1; return; }
        if (hipOccupancyMaxActiveBlocksPerMultiprocessor(&per_cu, (const void*)fwd_megakernel, NTHR, LDS_BYTES) != hipSuccess || per_cu < 1) { fprintf(stderr, "kernel_launch: occupancy query says %d\n", per_cu); per_cu = 1; }
        (void)hipGetLastError();
        grid = cus * 1;
        fprintf(stderr, "kernel_launch: grid %d (cus %d, per_cu %d)\n", grid, cus, per_cu);
    }
    if (grid < 0) return;
    Params p{};
    for (int i = 0; i < 23; ++i) p.in[i] = (const float*)d_in[i];
    p.out = (float*)d_out; p.ws = (unsigned char*)d_ws;
    if (hipMemsetAsync((char*)d_ws + WS_CTL, 0, CTL_BYTES, stream) != hipSuccess) { fprintf(stderr, "kernel_launch: memset failed\n"); return; }
#if MK_SPLIT
#ifndef MK_MAXPH
#define MK_MAXPH NPH
#endif
    for (int ph = 0; ph < MK_MAXPH; ++ph) {
        p.ph_lo = ph; p.ph_hi = ph + 1;
        hipLaunchKernelGGL(fwd_megakernel, dim3(grid), dim3(NTHR), LDS_BYTES, stream, p);
    }
#else
    p.ph_lo = 0; p.ph_hi = NPH;
    void* args[] = {&p};
    hipError_t e = hipLaunchCooperativeKernel((const void*)fwd_megakernel, dim3(grid), dim3(NTHR), args, LDS_BYTES, stream);
    if (e != hipSuccess) fprintf(stderr, "cooperative launch failed: %s (grid %d)\n", hipGetErrorString(e), grid);
#endif
}
```

```cpp
#include <hip/hip_runtime.h>
#include <hip/hip_cooperative_groups.h>
#include <cstdio>
#include <cstdint>
namespace cg = cooperative_groups;

#define LAS __attribute__((address_space(3)))
typedef unsigned short bf16_t;
typedef short bf16x8 __attribute__((ext_vector_type(8)));
typedef short s16x4 __attribute__((ext_vector_type(4)));
typedef float f32x4 __attribute__((ext_vector_type(4)));
typedef float f32x16 __attribute__((ext_vector_type(16)));
typedef unsigned u32x4 __attribute__((ext_vector_type(4)));

constexpr int DM = 1024, BATCH = 4, SEQ = 8192, DEPTH = 2, MTOK = BATCH * SEQ;
constexpr int DFF = 2816, INC = 1216;
constexpr float EPS = 1e-6f;
constexpr int NWAVES = 8, NTHR = 512;
constexpr int LDS_BYTES = 147456;

constexpr size_t MiB = 1u << 20;
constexpr size_t WS_W = 0, W_LAYER = 39 * MiB;
constexpr size_t OW_1T = 0, OW_1D = 11 * MiB, OW_2T = 16 * MiB + MiB / 2, OW_2D = 27 * MiB + MiB / 2, OW_IN = 33 * MiB, OW_O = 36 * MiB,
                 OW_QB = 38 * MiB, OW_KVB = 38 * MiB + 393216;
constexpr size_t WS_XSS = 78 * MiB, WS_CSS = 80 * MiB, WS_OSS = 82 * MiB;
constexpr size_t WS_XB = 84 * MiB;
constexpr size_t WS_ACT = 148 * MiB;
constexpr size_t WS_P = 148 * MiB, WS_KM = 232 * MiB, WS_QS = 280 * MiB, WS_KS = 312 * MiB;
constexpr size_t WS_QAKV = 324 * MiB;
constexpr size_t WS_MIX = 436 * MiB;
constexpr size_t WS_CTL = 500 * MiB, CTL_BYTES = 16384;
constexpr size_t WS_ROPE = 501 * MiB;
constexpr size_t WS_END = 503 * MiB;

__device__ __forceinline__ unsigned cvt_pk_bf16(float lo, float hi) { unsigned r; asm volatile("v_cvt_pk_bf16_f32 %0, %1, %2" : "=v"(r) : "v"(lo), "v"(hi)); return r; }
__device__ __forceinline__ float bf2f(bf16_t v) { return __uint_as_float(((unsigned)v) << 16); }
__device__ __forceinline__ bf16_t f2bf(float f) { return (bf16_t)(cvt_pk_bf16(f, 0.f) & 0xffffu); }
template <int M> __device__ __forceinline__ float shx(float v) {
    if constexpr (M == 32) { auto rr = __builtin_amdgcn_permlane32_swap(__float_as_uint(v), __float_as_uint(v), false, false);
        return __uint_as_float(rr[0]) == v ? __uint_as_float(rr[1]) : __uint_as_float(rr[0]); }
    else return __uint_as_float((unsigned)__builtin_amdgcn_ds_swizzle((int)__float_as_uint(v), 0x1F | (M << 10)));
}
__device__ __forceinline__ int lane_id_v() { int l; asm volatile("v_mbcnt_lo_u32_b32 %0, -1, 0\n\tv_mbcnt_hi_u32_b32 %0, -1, %0" : "=v"(l)); return l; }
__device__ __forceinline__ int tid_now(int wv) { return wv * 64 + lane_id_v(); }
__device__ __forceinline__ float wave_sum(float v) {
    v += shx<1>(v); v += shx<2>(v); v += shx<4>(v); v += shx<8>(v); v += shx<16>(v);
    { auto rr = __builtin_amdgcn_permlane32_swap(__float_as_uint(v), __float_as_uint(v), false, false); v = __uint_as_float(rr[0]) + __uint_as_float(rr[1]); }
    return v;
}

namespace pg8 {
constexpr int BM = 256, BK = 64, HALF = 128, HTB = HALF * BK * 2, NXCD = 8, WGM = 8;
__host__ __device__ __forceinline__ int lds_byte(int r, int c) { const int st = (r >> 4) * 2 + (c >> 5), rr = r & 15, cc = c & 31, ob = rr * 64 + cc * 2; return st * 1024 + (ob ^ (((ob >> 9) & 1) << 5)); }
__host__ __device__ __forceinline__ void stage_rc(int b, int& R, int& C) { const int st = b / 1024, sb = b % 1024, swz = sb ^ (((sb >> 9) & 1) << 5); R = (st >> 1) * 16 + swz / 64; C = (st & 1) * 32 + (swz % 64) / 2; }
__host__ __device__ __forceinline__ int perm32(int rho) { const int n = rho >> 4, i = rho & 15; return 8 * (i >> 2) + 4 * n + (i & 3); }

struct Unit { int pm, pn; };
struct Gemm { const bf16_t* A; const bf16_t* Bt; int lda, ldb, M, N, K; };

struct StaticOrder {
    int nM, nN, nwg, G, c;
    __device__ void init(int M, int N, int G_, int c_) { nM = M / BM; nN = N / BM; nwg = nM * nN; G = G_; c = c_; }
    __device__ bool next(int i, Unit& u) const {
        const long L = (long)i * G + c; if (L >= nwg) return false;
        int wgid = (int)L; { const int q = nwg / NXCD, r = nwg % NXCD, xcd = wgid % NXCD, off = wgid / NXCD; wgid = (xcd < r ? xcd * (q + 1) : r * (q + 1) + (xcd - r) * q) + off; }
        const int nig = WGM * nN, gid = wgid / nig, fm = gid * WGM, gsz = (nM - fm) < WGM ? (nM - fm) : WGM;
        u.pm = fm + ((wgid % nig) % gsz); u.pn = (wgid % nig) / gsz; return true;
    }
};

enum { MODE_SWIGLU = 0, MODE_RESID = 1, MODE_SCALE = 2 };
struct Epi {
    int mode;
    const float* stats; int np4; float inv_n;
    float alpha;
    const float* res; float* outf; bf16_t* outb; int ldc; int ncols; float* ssq; int wb;
    const float* mstats; int mid_t;
    __device__ __forceinline__ void mid(f32x4 (&acc)[2][2][4][2], const Unit& u, int wr, int fr, const LAS float* rsl) const {
#pragma unroll
        for (int ai = 0; ai < 2; ++ai)
#pragma unroll
            for (int m = 0; m < 4; ++m) {
                const float ratio = rsl[BM + ai * HALF + wr * 64 + m * 16 + fr];
#pragma unroll
                for (int bj = 0; bj < 2; ++bj)
#pragma unroll
                    for (int n = 0; n < 2; ++n) acc[ai][bj][m][n] = acc[ai][bj][m][n] * ratio;
            }
    }
    __device__ __forceinline__ void pre(const Unit& u, int wr, int fr, int tid, LAS float* rsl, int& cached_pm, float (&rs)[2][4]) const {
        if (np4 == 0) {
#pragma unroll
            for (int ai = 0; ai < 2; ++ai)
#pragma unroll
                for (int m = 0; m < 4; ++m) rs[ai][m] = alpha;
            return;
        }
        if (u.pm != cached_pm) {
            __builtin_amdgcn_s_barrier();
            if (tid < BM) { const float* sp = stats + (size_t)(u.pm * BM + tid) * 16; float t = 0.f;
                for (int q = 0; q < np4; ++q) { const f32x4 v = *(const f32x4*)(sp + 4 * q); t += (v[0] + v[1]) + (v[2] + v[3]); }
                float eps_ = EPS; asm volatile("" : "+s"(eps_));
                const float rb = rsqrtf(t * inv_n + eps_); rsl[tid] = rb;
                if (mstats) { const f32x4 a = *(const f32x4*)(mstats + (size_t)(u.pm * BM + tid) * 16); rsl[BM + tid] = rsqrtf(((a[0] + a[1]) + (a[2] + a[3])) * (1.f / 512.f) + eps_) / rb; } }
            asm volatile("s_waitcnt lgkmcnt(0)" ::: "memory");
            __builtin_amdgcn_s_barrier();
            cached_pm = u.pm;
        }
#pragma unroll
        for (int ai = 0; ai < 2; ++ai)
#pragma unroll
            for (int m = 0; m < 4; ++m) rs[ai][m] = rsl[ai * HALF + wr * 64 + m * 16 + fr] * alpha;
#pragma unroll
        for (int ai = 0; ai < 2; ++ai)
#pragma unroll
            for (int m = 0; m < 4; ++m) asm volatile("" : "+v"(rs[ai][m]));
    }
    __device__ __forceinline__ void operator()(const f32x4 (&acc)[2][2][4][2], const Unit& u, int wr, int wc, int fr, int fq, const float (&rs)[2][4]) const {
        const int row0 = u.pm * BM + wr * 64 + fr;
        if (mode == MODE_SWIGLU) {
            const int col0 = u.pn * 128 + wc * 32 + 8 * fq;
#pragma unroll
            for (int ai = 0; ai < 2; ++ai)
#pragma unroll
                for (int m = 0; m < 4; ++m) {
                    const int r = row0 + ai * HALF + m * 16; const float s = rs[ai][m], sl = s * -1.4426950408889634f, s2 = s * s;
                    float a[8];
#pragma unroll
                    for (int n = 0; n < 2; ++n)
#pragma unroll
                        for (int j = 0; j < 4; ++j) { const float ga = acc[ai][0][m][n][j], ua = acc[ai][1][m][n][j];
                            const float e = __builtin_amdgcn_exp2f(ga * sl), gu = (ga * ua) * s2;
                            a[4 * n + j] = gu * __builtin_amdgcn_rcpf(1.f + e); }
                    u32x4 w; w.x = cvt_pk_bf16(a[0], a[1]); w.y = cvt_pk_bf16(a[2], a[3]); w.z = cvt_pk_bf16(a[4], a[5]); w.w = cvt_pk_bf16(a[6], a[7]);
                    *(u32x4*)(outb + (size_t)r * ldc + col0) = w;
                }
        } else if (mode == MODE_RESID) {
            {
#define RLD(dst, it) do { if (!res) { _Pragma("unroll") for (int bj = 0; bj < 2; ++bj) dst[bj] = *(const u32x4*)(outb + (size_t)(row0 + ((it) >> 2) * HALF + ((it) & 3) * 16) * ldc + u.pn * BM + bj * HALF + wc * 32 + 8 * fq); } } while (0)
                u32x4 xc[2];
                RLD(xc, 0);
#pragma unroll
                for (int it = 0; it < 8; ++it) {
                    const int ai = it >> 2, m = it & 3;
                    const int r = row0 + ai * HALF + m * 16; const float s = rs[ai][m]; float sq = 0.f;
                    f32x4 v[2][2]; u32x4 w[2];
#pragma unroll
                    for (int bj = 0; bj < 2; ++bj) {
                        f32x4 x0, x1;
                        if (res) { const float* p = res + (size_t)r * ldc + u.pn * BM + bj * HALF + wc * 32 + 8 * fq; x0 = *(const f32x4*)p; x1 = *(const f32x4*)(p + 4); }
                        else { const u32x4 t = xc[bj];
                            x0 = (f32x4){__uint_as_float(t.x << 16), __uint_as_float(t.x & 0xffff0000u), __uint_as_float(t.y << 16), __uint_as_float(t.y & 0xffff0000u)};
                            x1 = (f32x4){__uint_as_float(t.z << 16), __uint_as_float(t.z & 0xffff0000u), __uint_as_float(t.w << 16), __uint_as_float(t.w & 0xffff0000u)}; }
                        v[bj][0] = x0 + acc[ai][bj][m][0] * s; v[bj][1] = x1 + acc[ai][bj][m][1] * s;
                        w[bj].x = cvt_pk_bf16(v[bj][0][0], v[bj][0][1]); w[bj].y = cvt_pk_bf16(v[bj][0][2], v[bj][0][3]); w[bj].z = cvt_pk_bf16(v[bj][1][0], v[bj][1][1]); w[bj].w = cvt_pk_bf16(v[bj][1][2], v[bj][1][3]);
                        sq += (v[bj][0][0] * v[bj][0][0] + v[bj][0][1] * v[bj][0][1]) + (v[bj][0][2] * v[bj][0][2] + v[bj][0][3] * v[bj][0][3]) + (v[bj][1][0] * v[bj][1][0] + v[bj][1][1] * v[bj][1][1]) + (v[bj][1][2] * v[bj][1][2] + v[bj][1][3] * v[bj][1][3]);
                    }
                    if (it + 1 < 8) RLD(xc, it + 1);
#pragma unroll
                    for (int bj = 0; bj < 2; ++bj) {
                        const int c0 = u.pn * BM + bj * HALF + wc * 32 + 8 * fq;
                        if (outf) { *(f32x4*)(outf + (size_t)r * ldc + c0) = v[bj][0]; *(f32x4*)(outf + (size_t)r * ldc + c0 + 4) = v[bj][1]; }
                        *(u32x4*)(outb + (size_t)r * ldc + c0) = w[bj];
                    }
                    sq += shx<16>(sq); { auto rr_ = __builtin_amdgcn_permlane32_swap(__float_as_uint(sq), __float_as_uint(sq), false, false); sq = __uint_as_float(rr_[0]) + __uint_as_float(rr_[1]); }
                    if (fq == 0) ssq[(size_t)r * 16 + u.pn * 4 + wc] = sq;
                }
#undef RLD
            }
        } else {
            const bool do_ss = (ssq != nullptr) && (u.pn < 2);
#pragma unroll
            for (int ai = 0; ai < 2; ++ai)
#pragma unroll
                for (int m = 0; m < 4; ++m) {
                    const int r = row0 + ai * HALF + m * 16; const float s = rs[ai][m]; float sq = 0.f;
#pragma unroll
                    for (int bj = 0; bj < 2; ++bj) {
                        const int c0 = u.pn * BM + bj * HALF + wc * 32 + 8 * fq;
                        const f32x4 v0 = acc[ai][bj][m][0] * s, v1 = acc[ai][bj][m][1] * s;
                        if (c0 < ncols) {
                            u32x4 w; w.x = cvt_pk_bf16(v0[0], v0[1]); w.y = cvt_pk_bf16(v0[2], v0[3]); w.z = cvt_pk_bf16(v1[0], v1[1]); w.w = cvt_pk_bf16(v1[2], v1[3]);
                            *(u32x4*)(outb + (size_t)r * ldc + c0) = w;
                        }
                        if (bj == 0 || u.pn == 0)
                            sq += (v0[0] * v0[0] + v0[1] * v0[1]) + (v0[2] * v0[2] + v0[3] * v0[3]) + (v1[0] * v1[0] + v1[1] * v1[1]) + (v1[2] * v1[2] + v1[3] * v1[3]);
                    }
                    if (do_ss) { sq += shx<16>(sq); { auto rr_ = __builtin_amdgcn_permlane32_swap(__float_as_uint(sq), __float_as_uint(sq), false, false); sq = __uint_as_float(rr_[0]) + __uint_as_float(rr_[1]); } if (fq == 0) ssq[(size_t)r * 16 + u.pn * 4 + wc] = sq; }
                }
        }
    }
};

__device__ __forceinline__ void gemm_phase(LAS unsigned char* lds, const Gemm g, const StaticOrder& S, const Epi& E, int wv) {
    const int tid_ = tid_now(wv);
    const int tid = tid_, wid = __builtin_amdgcn_readfirstlane(tid >> 6), lane = tid & 63, wr = wid >> 2, wc = wid & 3, fr = lane & 15, fq = lane >> 4;
    const int K = g.K, nt = K / BK;
    unsigned voffA[2], voffB[2];
#pragma unroll
    for (int i = 0; i < 2; ++i) { int R, C; stage_rc(tid * 16 + i * 8192, R, C); const int Rb = (R & ~31) + perm32(R & 31);
        voffA[i] = (unsigned)(R * g.lda + C) * 2u; voffB[i] = (unsigned)(Rb * g.ldb + C) * 2u; }
    const size_t kstep = (size_t)(BK * 2);
    const size_t hstepA = (size_t)HALF * g.lda * 2, hstepB = (size_t)HALF * g.ldb * 2;
    const size_t tstepA = 2 * hstepA, tstepB = 2 * hstepB;
    const unsigned ldsw = (unsigned)wid * 1024u;
    const int aoff = lds_byte(wr * 64 + fr, fq * 8), boff = lds_byte(wc * 32 + fr, fq * 8);
#define PG8_SA(b, h) (((b) * 2 + (h)) * HTB)
#define PG8_SB(b, h) ((4 + (b) * 2 + (h)) * HTB)
#define PG8_STAGE(bufoff, gbase, voff) do { _Pragma("unroll") for (int _i = 0; _i < 2; ++_i) \
        __builtin_amdgcn_global_load_lds((const unsigned*)((const char*)(gbase) + (voff)[_i]), (LAS unsigned*)(lds + (bufoff) + ldsw + _i * 8192), 16, 0, 0); } while (0)
#define PG8_LDA(dst, b, h) do { _Pragma("unroll") for (int m = 0; m < 4; ++m) _Pragma("unroll") for (int k = 0; k < 2; ++k) dst[m][k] = *(const LAS bf16x8*)(lds + PG8_SA(b, h) + aoff + m * 2048 + k * 1024); } while (0)
#define PG8_LDB(dst, b, h) do { _Pragma("unroll") for (int n = 0; n < 2; ++n) _Pragma("unroll") for (int k = 0; k < 2; ++k) dst[n][k] = *(const LAS bf16x8*)(lds + PG8_SB(b, h) + boff + n * 2048 + k * 1024); } while (0)
#define PG8_MMA(ai, bj, At, Bt) do { __builtin_amdgcn_s_setprio(1); _Pragma("unroll") for (int m = 0; m < 4; ++m) _Pragma("unroll") for (int n = 0; n < 2; ++n) _Pragma("unroll") for (int k = 0; k < 2; ++k) \
        acc[ai][bj][m][n] = __builtin_amdgcn_mfma_f32_16x16x32_bf16(Bt[n][k], At[m][k], acc[ai][bj][m][n], 0, 0, 0); __builtin_amdgcn_s_setprio(0); } while (0)
#define PG8_WAIT_V(n) asm volatile("s_waitcnt vmcnt(" #n ")" ::: "memory")
#define PG8_WAIT_L(n) asm volatile("s_waitcnt lgkmcnt(" #n ")" ::: "memory")
#define PG8_BAR __builtin_amdgcn_s_barrier()
#define PG8_SCHED __builtin_amdgcn_sched_barrier(0)
    Unit cur, nxt; int ui = 0;
    if (!S.next(0, cur)) return;
    f32x4 acc[2][2][4][2];
#pragma unroll
    for (int a = 0; a < 2; ++a)
#pragma unroll
        for (int b = 0; b < 2; ++b)
#pragma unroll
            for (int m = 0; m < 4; ++m)
#pragma unroll
                for (int n = 0; n < 2; ++n) acc[a][b][m][n] = (f32x4){0.f, 0.f, 0.f, 0.f};
    bf16x8 At[4][2], B0[2][2], B1[2][2];
    LAS float* rsl = (LAS float*)(lds + 131072 + 1024); int cached_pm = -1;
    float rs[2][4];
    const char* cA = (const char*)g.A + (size_t)cur.pm * tstepA; const char* cB = (const char*)g.Bt + (size_t)cur.pn * tstepB;
    PG8_STAGE(PG8_SB(0, 0), cB, voffB); PG8_STAGE(PG8_SB(0, 1), cB + hstepB, voffB); PG8_STAGE(PG8_SA(0, 0), cA, voffA); PG8_STAGE(PG8_SA(0, 1), cA + hstepA, voffA);
    E.pre(cur, wr, fr, tid, rsl, cached_pm, rs);
    if (wr == 1) PG8_BAR;
    PG8_WAIT_V(2); PG8_BAR;
    PG8_STAGE(PG8_SB(1, 0), cB + kstep, voffB); PG8_STAGE(PG8_SA(1, 0), cA + kstep, voffA); PG8_STAGE(PG8_SB(1, 1), cB + hstepB + kstep, voffB);
    PG8_WAIT_V(6); PG8_BAR;
    for (;;) {
        const bool has_next = S.next(ui + 1, nxt);
        const char* nA = has_next ? (const char*)g.A + (size_t)nxt.pm * tstepA : cA; const char* nB = has_next ? (const char*)g.Bt + (size_t)nxt.pn * tstepB : cB;
        for (int t = 0; t < nt; t += 2) {
            const bool last = (t == nt - 2);
            const char* a1 = cA + (size_t)(t + 1) * kstep;
            const char* a2 = last ? nA : cA + (size_t)(t + 2) * kstep; const char* b2 = last ? nB : cB + (size_t)(t + 2) * kstep;
            const char* a3 = a2 + kstep; const char* b3 = b2 + kstep;
            if (t == E.mid_t) E.mid(acc, cur, wr, fr, rsl);
            PG8_LDB(B0, 0, 0); PG8_LDB(B1, 0, 1); PG8_SCHED; PG8_LDA(At, 0, 0); PG8_STAGE(PG8_SA(1, 1), a1 + hstepA, voffA);
            PG8_WAIT_V(8); PG8_WAIT_L(0); PG8_BAR; PG8_MMA(0, 0, At, B0); PG8_MMA(0, 1, At, B1); PG8_BAR; PG8_SCHED;
            PG8_LDA(At, 0, 1); PG8_STAGE(PG8_SB(0, 0), b2, voffB); PG8_STAGE(PG8_SB(0, 1), b2 + hstepB, voffB); PG8_STAGE(PG8_SA(0, 0), a2, voffA);
            PG8_WAIT_V(8); PG8_WAIT_L(0); PG8_BAR; PG8_MMA(1, 0, At, B0); PG8_MMA(1, 1, At, B1); PG8_BAR; PG8_SCHED;
            PG8_LDB(B0, 1, 0); PG8_LDB(B1, 1, 1); PG8_SCHED; PG8_LDA(At, 1, 0); PG8_STAGE(PG8_SA(0, 1), a2 + hstepA, voffA);
            PG8_WAIT_V(8); PG8_WAIT_L(0); PG8_BAR; PG8_MMA(0, 0, At, B0); PG8_MMA(0, 1, At, B1); PG8_BAR; PG8_SCHED;
            PG8_LDA(At, 1, 1); PG8_STAGE(PG8_SB(1, 0), b3, voffB); PG8_STAGE(PG8_SB(1, 1), b3 + hstepB, voffB); PG8_STAGE(PG8_SA(1, 0), a3, voffA);
            PG8_WAIT_V(8); PG8_WAIT_L(0); PG8_BAR; PG8_MMA(1, 0, At, B0); PG8_MMA(1, 1, At, B1); PG8_BAR; PG8_SCHED;
        }
        if (wr == 0) PG8_BAR;
        E(acc, cur, wr, wc, fr, fq, rs);
        if (!has_next) break;
        E.pre(nxt, wr, fr, tid, rsl, cached_pm, rs);
#pragma unroll
        for (int a = 0; a < 2; ++a)
#pragma unroll
            for (int b = 0; b < 2; ++b)
#pragma unroll
                for (int m = 0; m < 4; ++m)
#pragma unroll
                    for (int n = 0; n < 2; ++n) acc[a][b][m][n] = (f32x4){0.f, 0.f, 0.f, 0.f};
        cur = nxt; cA = nA; cB = nB; ++ui;
        if (wr == 1) PG8_BAR;
    }
    PG8_WAIT_V(0);
    PG8_BAR;
#undef PG8_SA
#undef PG8_SB
#undef PG8_STAGE
#undef PG8_LDA
#undef PG8_LDB
#undef PG8_MMA
#undef PG8_WAIT_V
#undef PG8_WAIT_L
#undef PG8_BAR
#undef PG8_SCHED
}
}

namespace att {
constexpr int NW = 8, QBLK = 32, KVBLK = 64, QB = NW * QBLK;
struct CfgMLA { static constexpr int DQK = 192, DV = 128, LDQ = 1792, LDK = 192, LDV = 1792, LDO = 1024, W = SEQ; static constexpr bool SK = true, SINK = false, STAGGER = true, GQA4 = false; static constexpr float SCALE = 0.07216878364870322f; };
struct CfgSWA { static constexpr int DQK = 64, DV = 64, LDQ = INC, LDK = 64, LDV = INC, LDO = 1024, W = 128; static constexpr bool SK = true, SINK = true, STAGGER = false, GQA4 = true; static constexpr float SCALE = 0.125f; };
template <class C> struct Geo {
    static constexpr int KROWB = C::DQK * 2, KCH = (KVBLK * C::DQK / 8) / 512, SHM_K = KVBLK * C::DQK * 2;
    static constexpr int SHM_V = KVBLK * C::DV * 2;
    static constexpr int NKC = C::DQK / 16, NDV = C::DV / 32, VCH = (KVBLK * C::DV / 8) / 512;
    static constexpr int VCB = C::DV / 32;
    static constexpr int LDS_NEED = 2 * SHM_K + 2 * SHM_V + NW * 64 * 4;
};
#define SBAR() __builtin_amdgcn_sched_barrier(0)
__device__ __forceinline__ int crow(int r, int hi) { return (r & 3) + 8 * (r >> 2) + 4 * hi; }
__device__ __forceinline__ bf16x8 ld8(const bf16_t* p) { return *reinterpret_cast<const bf16x8*>(p); }
template <class C> __device__ __forceinline__ int kswz(int row, int colB) { return row * Geo<C>::KROWB + (colB ^ ((row & 7) << 4)); }
template <class C> __device__ __forceinline__ int v_st(int k, int c) { const int kk = (k & ~0xC) | ((k & 4) << 1) | ((k & 8) >> 1); return ((kk >> 3) * Geo<C>::VCB + (c >> 5)) * 512 + ((kk & 7) * 32 + (c & 31)) * 2; }
__device__ __forceinline__ int v_rd_base(int lane) { return ((lane & 3) << 3) | (((lane >> 2) & 3) << 6) | (((lane >> 4) & 1) << 5) | (((lane >> 5) & 1) << 8); }

__device__ __forceinline__ void mask_tile(f32x16& p0, f32x16& p1, int dq, unsigned W) {
    float NEG = -__builtin_inff(); asm volatile("" : "+s"(NEG));
#pragma unroll
    for (int r = 0; r < 16; ++r) {
        const int c = (r & 3) + 8 * (r >> 2);
        if ((unsigned)(dq - c) >= W) p0[r] = NEG;
        if ((unsigned)(dq - c - 32) >= W) p1[r] = NEG;
    }
}
template <class C> __device__ __forceinline__ void partialSM(f32x16& p0, f32x16& p1, float mfix) {
    constexpr float C2 = 1.4426950408889634f * C::SCALE;
    const float mnL = -mfix * C2;
#pragma unroll
    for (int r = 0; r < 16; ++r) p0[r] = fmaf(p0[r], C2, mnL);
#pragma unroll
    for (int r = 0; r < 16; ++r) p1[r] = fmaf(p1[r], C2, mnL);
#pragma unroll
    for (int r = 0; r < 16; ++r) p0[r] = __builtin_amdgcn_exp2f(p0[r]);
}
__device__ __forceinline__ void finishSM(f32x16& p0, f32x16& p1, float& l_reg, bf16x8& pa0, bf16x8& pa1, bf16x8& pa2, bf16x8& pa3) {
#pragma unroll
    for (int r = 0; r < 16; ++r) p1[r] = __builtin_amdgcn_exp2f(p1[r]);
    float ps = 0;
#pragma unroll
    for (int r = 0; r < 16; ++r) ps += p0[r];
#pragma unroll
    for (int r = 0; r < 16; ++r) ps += p1[r];
    { auto rr = __builtin_amdgcn_permlane32_swap(__float_as_uint(ps), __float_as_uint(ps), false, false);
      ps = __uint_as_float(rr[0]) + __uint_as_float(rr[1]); }
    l_reg += ps;
#define PK4(P, B_, OUT) do { unsigned a0 = cvt_pk_bf16(P[B_+0], P[B_+1]), a1 = cvt_pk_bf16(P[B_+2], P[B_+3]);                          \
        unsigned b0 = cvt_pk_bf16(P[B_+4], P[B_+5]), b1 = cvt_pk_bf16(P[B_+6], P[B_+7]);                                             \
        auto r0 = __builtin_amdgcn_permlane32_swap(a0, b0, false, false); auto r1 = __builtin_amdgcn_permlane32_swap(a1, b1, false, false); \
        u32x4 w = {r0[0], r1[0], r0[1], r1[1]}; OUT = *reinterpret_cast<bf16x8*>(&w); } while (0)
    PK4(p0, 0, pa0); PK4(p0, 8, pa1); PK4(p1, 0, pa2); PK4(p1, 8, pa3);
#undef PK4
}
template <int N> __device__ __forceinline__ void wait_lgkm() { asm volatile("s_waitcnt lgkmcnt(%0)" :: "i"(N) : "memory"); }
template <class C, int D> __device__ __forceinline__ void krd(bf16x8& a, bf16x8& b, int kaddr) {
    constexpr int off = (D >> 2) * 128;
    asm volatile("ds_read_b128 %0, %1 offset:%2" : "=&v"(a) : "v"(kaddr), "i"(off) : "memory");
    asm volatile("ds_read_b128 %0, %1 offset:%2" : "=&v"(b) : "v"(kaddr), "i"(off + 32 * Geo<C>::KROWB) : "memory");
}
template <class C, int D> struct QkStep {
    static __device__ __forceinline__ void run(f32x16& p0, f32x16& p1, bf16x8 (&k0r)[3], bf16x8 (&k1r)[3], const int (&ka)[4], const bf16x8* qr) {
        constexpr int NKC = Geo<C>::NKC;
        if constexpr (D + 2 < NKC) krd<C, D + 2>(k0r[(D + 2) % 3], k1r[(D + 2) % 3], ka[(D + 2) & 3]);
        wait_lgkm<(D + 2 < NKC) ? 4 : ((D + 1 < NKC) ? 2 : 0)>(); SBAR();
        p0 = __builtin_amdgcn_mfma_f32_32x32x16_bf16(k0r[D % 3], qr[D], p0, 0, 0, 0);
        p1 = __builtin_amdgcn_mfma_f32_32x32x16_bf16(k1r[D % 3], qr[D], p1, 0, 0, 0); SBAR();
        if constexpr (D + 1 < NKC) QkStep<C, D + 1>::run(p0, p1, k0r, k1r, ka, qr);
    }
};
template <class C>
__device__ __forceinline__ void qkt(f32x16& p0, f32x16& p1, const char* Kbuf, int r32, int hi, const bf16x8* qr, bool act) {
    if (C::SK && !act) { const float NEG = -__builtin_inff();
#pragma unroll
        for (int r = 0; r < 16; ++r) { p0[r] = NEG; p1[r] = NEG; } return; }
    p0 = f32x16{}; p1 = f32x16{};
    const int kbase = (int)(uintptr_t)Kbuf;
    int ka[4];
#pragma unroll
    for (int dd = 0; dd < 4; ++dd) ka[dd] = kbase + kswz<C>(r32, (dd * 16 + hi * 8) * 2);
    bf16x8 k0r[3], k1r[3];
    asm volatile("s_waitcnt lgkmcnt(0)" ::: "memory");
    krd<C, 0>(k0r[0], k1r[0], ka[0]);
    if constexpr (Geo<C>::NKC > 1) krd<C, 1>(k0r[1], k1r[1], ka[1]);
    QkStep<C, 0>::run(p0, p1, k0r, k1r, ka, qr);
}
template <class C>
__device__ __forceinline__ void pv_tile(f32x16* o, int vb0, bf16x8 pa0, bf16x8 pa1, bf16x8 pa2, bf16x8 pa3, bool act) {
    if (C::SK && !act) return;
    constexpr int KS = 2 * Geo<C>::VCB * 512, HF = Geo<C>::VCB * 512, NDV = Geo<C>::NDV;
#define TRRD(dst, off) asm volatile("ds_read_b64_tr_b16 %0, %1 offset:%2" : "=&v"(dst) : "v"(vb0), "i"(off) : "memory")
#define VSET(S_, d) do { constexpr int b_ = (d) * 512; TRRD(S_[0], b_); TRRD(S_[1], b_ + HF); TRRD(S_[2], b_ + KS); TRRD(S_[3], b_ + KS + HF); TRRD(S_[4], b_ + 2 * KS); TRRD(S_[5], b_ + 2 * KS + HF); TRRD(S_[6], b_ + 3 * KS); TRRD(S_[7], b_ + 3 * KS + HF); } while (0)
#define VMMA(S_, d) do { \
        o[d] = __builtin_amdgcn_mfma_f32_32x32x16_bf16(pa0, (bf16x8){S_[0][0], S_[0][1], S_[0][2], S_[0][3], S_[1][0], S_[1][1], S_[1][2], S_[1][3]}, o[d], 0, 0, 0); \
        o[d] = __builtin_amdgcn_mfma_f32_32x32x16_bf16(pa1, (bf16x8){S_[2][0], S_[2][1], S_[2][2], S_[2][3], S_[3][0], S_[3][1], S_[3][2], S_[3][3]}, o[d], 0, 0, 0); \
        o[d] = __builtin_amdgcn_mfma_f32_32x32x16_bf16(pa2, (bf16x8){S_[4][0], S_[4][1], S_[4][2], S_[4][3], S_[5][0], S_[5][1], S_[5][2], S_[5][3]}, o[d], 0, 0, 0); \
        o[d] = __builtin_amdgcn_mfma_f32_32x32x16_bf16(pa3, (bf16x8){S_[6][0], S_[6][1], S_[6][2], S_[6][3], S_[7][0], S_[7][1], S_[7][2], S_[7][3]}, o[d], 0, 0, 0); } while (0)
#define WL8() do { asm volatile("s_waitcnt lgkmcnt(8)" ::: "memory"); SBAR(); } while (0)
#define WL0() do { asm volatile("s_waitcnt lgkmcnt(0)" ::: "memory"); SBAR(); } while (0)
    s16x4 A[8], B[8];
    VSET(A, 0);
    if (NDV == 2) { VSET(B, 1); WL8(); VMMA(A, 0); WL0(); VMMA(B, 1); }
    else { VSET(B, 1); WL8(); VMMA(A, 0); SBAR(); VSET(A, 2); WL8(); VMMA(B, 1); SBAR(); VSET(B, 3); WL8(); VMMA(A, 2); WL0(); VMMA(B, 3); }
#undef TRRD
#undef VSET
#undef VMMA
#undef WL8
#undef WL0
}

struct BlockRef { const bf16_t* Q; const bf16_t* K; const bf16_t* V; bf16_t* O; float* SS; int P0; const float* sinks; };
template <class C> __device__ __forceinline__ void load_q(bf16x8* qr, const bf16_t* qrow, const float* gq, const float* ropep, int hi) {
    constexpr int NKC = Geo<C>::NKC, R0 = (C::DQK - 64) / 16;
    float x[NKC][8]; float ss = 0.f;
#pragma unroll
    for (int d0 = 0; d0 < NKC; ++d0) { const bf16x8 t = ld8(qrow + d0 * 16 + hi * 8);
#pragma unroll
        for (int e = 0; e < 8; ++e) { x[d0][e] = bf2f((bf16_t)t[e]); ss += x[d0][e] * x[d0][e]; } }
    { auto rr = __builtin_amdgcn_permlane32_swap(__float_as_uint(ss), __float_as_uint(ss), false, false); ss = __uint_as_float(rr[0]) + __uint_as_float(rr[1]); }
    const float rstd = rsqrtf(ss * (1.f / C::DQK) + EPS);
#pragma unroll
    for (int d0 = 0; d0 < NKC; ++d0) { const f32x4 g0 = *(const f32x4*)(gq + d0 * 16 + hi * 8), g1 = *(const f32x4*)(gq + d0 * 16 + hi * 8 + 4);
#pragma unroll
        for (int e = 0; e < 4; ++e) { x[d0][e] *= rstd * g0[e]; x[d0][4 + e] *= rstd * g1[e]; } }
#pragma unroll
    for (int k = 0; k < 2; ++k) { const f32x4* rt = (const f32x4*)(ropep + k * 32 + hi * 16);
#pragma unroll
        for (int q = 0; q < 4; ++q) { const f32x4 t = rt[q];
#pragma unroll
            for (int w = 0; w < 2; ++w) { const float c = t[2 * w], sn = t[2 * w + 1], a = x[R0 + k][2 * q + w], b = x[R0 + k + 2][2 * q + w];
                x[R0 + k][2 * q + w] = a * c - b * sn; x[R0 + k + 2][2 * q + w] = b * c + a * sn; } } }
#pragma unroll
    for (int d0 = 0; d0 < NKC; ++d0) { u32x4 w; w.x = cvt_pk_bf16(x[d0][0], x[d0][1]); w.y = cvt_pk_bf16(x[d0][2], x[d0][3]); w.z = cvt_pk_bf16(x[d0][4], x[d0][5]); w.w = cvt_pk_bf16(x[d0][6], x[d0][7]);
        qr[d0] = *reinterpret_cast<bf16x8*>(&w); }
}

__device__ __forceinline__ int swa_jlo(int P0, int W) { const int lowk = P0 - W + 1; return lowk > 0 ? lowk / KVBLK : 0; }

template <class C> __device__ __forceinline__ void dma_v(const bf16_t* Vp, int k0, LAS unsigned char* Vbuf, int tid, int wid) {
#pragma unroll
    for (int i = 0; i < Geo<C>::VCH; ++i) { const int p = tid + 512 * i, sub = p >> 5, q = p & 31, kk = (sub / Geo<C>::VCB) * 8 + (q >> 2), cc = (sub % Geo<C>::VCB) * 32 + (q & 3) * 8;
        const int k = (kk & ~0xC) | ((kk & 4) << 1) | ((kk & 8) >> 1);
        __builtin_amdgcn_global_load_lds((const unsigned*)(Vp + (size_t)(k0 + k) * C::LDV + cc), (LAS unsigned*)(Vbuf + (i * 512 + wid * 64) * 16), 16, 0, 0); }
}
template <class C> __device__ __forceinline__ void dma_k(const bf16_t* Kp, int k0, LAS unsigned char* Kbuf, int tid, int wid) {
#pragma unroll
    for (int i = 0; i < Geo<C>::KCH; ++i) { const int p = tid + 512 * i, row = p / (C::DQK / 8), csw = p % (C::DQK / 8), ch = csw ^ (row & 7);
        __builtin_amdgcn_global_load_lds((const unsigned*)(Kp + (size_t)(k0 + row) * C::LDK + ch * 8), (LAS unsigned*)(Kbuf + (i * 512 + wid * 64) * 16), 16, 0, 0); }
}
#define VMW() asm volatile("s_waitcnt vmcnt(0)" ::: "memory")

template <class C>
__device__ __forceinline__ void attn_block(const BlockRef& cur, char* lds, const float* gq, const float* rope, float mfix, int wv, const BlockRef& nxt, bool has_next, bool primed) {
    using G = Geo<C>;
    constexpr int W = C::W, skv = SEQ;
    constexpr bool SK = C::SK;
    const int tid_ = tid_now(wv);
    const int tid = tid_, wid = wv, lane = tid & 63, r32 = lane & 31, hi = lane >> 5;
    const int j_lo = swa_jlo(cur.P0, W);
    constexpr int RQB = C::GQA4 ? 2 * QBLK : QB;
    const int wrow = C::GQA4 ? (wid & 1) * QBLK : wid * QBLK, hs = C::GQA4 ? (wid >> 1) : 0;
    int j_hi = (cur.P0 + RQB - 1) / KVBLK + 1; if (j_hi > skv / KVBLK) j_hi = skv / KVBLK;
    const int NT = j_hi - j_lo;
    const int qlo = cur.P0 + wrow, qm = qlo + r32 - 4 * hi;
    char* V_lds = lds; char* K_lds = lds + 2 * G::SHM_V;
    float* ws = (float*)(lds + 2 * G::SHM_V + 2 * G::SHM_K) + wid * 64; float* li_l = ws, * al_l = ws + 32;
    const float m_reg = mfix; float l_reg = 0; f32x16 o[G::NDV];
#pragma unroll
    for (int d = 0; d < G::NDV; ++d) o[d] = f32x16{};
    const int vb0 = (int)(uintptr_t)V_lds + v_rd_base(lane);
    const bf16_t* Kh = cur.K; const bf16_t* Vh = cur.V;
    bf16x8 qr[G::NKC];
    LAS unsigned char* Vl = (LAS unsigned char*)V_lds; LAS unsigned char* Kl = (LAS unsigned char*)K_lds;
    load_q<C>(qr, cur.Q + hs * C::DQK + (size_t)(wrow + r32) * C::LDQ, gq, rope + (size_t)(cur.P0 + wrow + r32) * 64, hi);
#define KBASE(t) ((j_lo + (t)) * KVBLK)
#define ACT(t) (KBASE(t) <= qlo + QBLK - 1 && KBASE(t) + KVBLK - 1 >= qlo - W + 1)
    if (!primed) { dma_k<C>(Kh, KBASE(0), Kl, tid, wid); dma_v<C>(Vh, KBASE(0), Vl, tid, wid); }
    VMW();
    __syncthreads();
    f32x16 p0, p1;
#define WAITB(issued, n) do { if (issued) asm volatile("s_waitcnt vmcnt(%0) lgkmcnt(0)" :: "i"(n) : "memory"); else asm volatile("s_waitcnt vmcnt(0) lgkmcnt(0)" ::: "memory"); __syncthreads(); } while (0)
#define QK(t) do { const bool act_ = ACT(t); SBAR(); qkt<C>(p0, p1, K_lds + ((t) & 1) * G::SHM_K, r32, hi, qr, act_); SBAR();                             \
        { const int kb_ = KBASE(t); if ((!SK || act_) && (kb_ + KVBLK - 1 > qlo || kb_ <= qlo + QBLK - 1 - W)) mask_tile(p0, p1, qm - kb_, (unsigned)W); } \
        partialSM<C>(p0, p1, m_reg); SBAR(); } while (0)
#define SMPV(t) do { bf16x8 pa0, pa1, pa2, pa3; const bool act_ = ACT(t); SBAR();                                                                  \
        finishSM(p0, p1, l_reg, pa0, pa1, pa2, pa3); SBAR();                                                                                       \
        pv_tile<C>(o, vb0 + ((t) & 1) * G::SHM_V, pa0, pa1, pa2, pa3, act_); SBAR(); } while (0)
    if (wid >= 4) __builtin_amdgcn_s_setprio(1);
    if constexpr (!C::STAGGER) {
        for (int t = 0; t < NT; ++t) {
            const bool is = t + 1 < NT;
            if (is) { dma_k<C>(Kh, KBASE(t + 1), Kl + ((t + 1) & 1) * G::SHM_K, tid, wid); dma_v<C>(Vh, KBASE(t + 1), Vl + ((t + 1) & 1) * G::SHM_V, tid, wid); }
            QK(t); SMPV(t); WAITB(false, 0);
        }
    } else if (wid < 4) {
        for (int t = 0; t < NT; ++t) {
            const bool is = t + 1 < NT;
            if (is) dma_k<C>(Kh, KBASE(t + 1), Kl + ((t + 1) & 1) * G::SHM_K, tid, wid);
            QK(t); WAITB(is, G::KCH);
            if (is) dma_v<C>(Vh, KBASE(t + 1), Vl + ((t + 1) & 1) * G::SHM_V, tid, wid);
            SMPV(t); WAITB(is, G::VCH);
        }
        WAITB(false, 0);
    } else {
        { const bool ik = 1 < NT; if (ik) dma_k<C>(Kh, KBASE(1), Kl + G::SHM_K, tid, wid); WAITB(ik, G::KCH); }
        for (int t = 0; t < NT; ++t) {
            const bool iv = t + 1 < NT, ik = t + 2 < NT;
            if (iv) dma_v<C>(Vh, KBASE(t + 1), Vl + ((t + 1) & 1) * G::SHM_V, tid, wid);
            QK(t); WAITB(iv, G::VCH);
            if (ik) dma_k<C>(Kh, KBASE(t + 2), Kl + (t & 1) * G::SHM_K, tid, wid);
            SMPV(t); WAITB(ik, G::KCH);
        }
    }
    __builtin_amdgcn_s_setprio(0);
#undef WAITB
#undef QK
#undef SMPV
    if (has_next) { const int kn = swa_jlo(nxt.P0, W) * KVBLK; dma_k<C>(nxt.K, kn, Kl, tid, wid); dma_v<C>(nxt.V, kn, Vl, tid, wid); }
    if (C::SINK) l_reg += __builtin_amdgcn_exp2f(cur.sinks[hs] * 1.4426950408889634f - m_reg * (1.4426950408889634f * C::SCALE));
    if (hi == 0) li_l[r32] = l_reg; asm volatile("s_waitcnt lgkmcnt(0)" ::: "memory");
    int hi_e = hi, r32_e = r32; asm volatile("" : "+v"(hi_e), "+v"(r32_e));
    bf16_t* Ow = cur.O + hs * C::DV + (size_t)(wrow + 4 * hi_e) * C::LDO + r32_e;
    float* SSw = cur.SS + hs + (size_t)(wrow + 4 * hi_e) * 16;
#pragma unroll
    for (int r = 0; r < 16; ++r) { const int orow0 = (r & 3) + 8 * (r >> 2); float sq = 0.f; const float rl = __builtin_amdgcn_rcpf(li_l[crow(r, hi)]);
#pragma unroll
        for (int d0 = 0; d0 < G::NDV; ++d0) { const float v = o[d0][r] * rl; sq += v * v;
            const float vn = shx<1>(v);
            if ((r32 & 1) == 0) *(unsigned*)(Ow + orow0 * C::LDO + d0 * 32) = cvt_pk_bf16(v, vn); }
        sq += shx<1>(sq); sq += shx<2>(sq); sq += shx<4>(sq); sq += shx<8>(sq); sq += shx<16>(sq);
        if (r32 == 0) SSw[orow0 * 16] = sq; }
    __syncthreads();
#undef KBASE
#undef ACT
}

__device__ __forceinline__ int swa_nramp(int nqb, int W) { const int t = W - 1; const int n = t < 0 ? 0 : t / QB + 1; return n > nqb ? nqb : n; }
struct Item { int bh, qb0, qb1; };
__device__ __forceinline__ Item decode(int L, int nqb, int nx, int nramp) {
    Item it; it.bh = L / nx; const int x = L - it.bh * nx; const int ns = nqb - nramp;
    if (x < ns) { it.qb0 = it.qb1 = nqb - 1 - x; } else { it.qb0 = x - ns; it.qb1 = nramp - 1 - it.qb0; }
    return it;
}
struct Tensors { const bf16_t* qakv; const bf16_t* km; const bf16_t* p; const bf16_t* ks; bf16_t* mix; float* oss; const float* sinks; const float* gq_mla; const float* gq_swa; const float* gk_mla; const float* gk_swa; const float* rope; };
template <class C> __device__ __forceinline__ BlockRef make_ref(const Tensors& T, const Item& it, int pass) {
    const int qb = pass ? it.qb1 : it.qb0; BlockRef r; r.sinks = T.sinks;
    if (!C::SINK) {
        r.P0 = qb * QB;
        const int b = it.bh >> 2, h = it.bh & 3; const size_t m0 = (size_t)b * SEQ;
        r.Q = T.qakv + (m0 + r.P0) * 1792 + h * 192; r.K = T.km + (size_t)it.bh * SEQ * 192; r.V = T.qakv + m0 * 1792 + 768 + h * 256 + 128;
        r.O = T.mix + (m0 + r.P0) * 1024 + h * 128; r.SS = T.oss + (m0 + r.P0) * 16 + h;
    } else {
        r.P0 = qb * 2 * QBLK;
        const int b = it.bh >> 1, kvh = it.bh & 1; const size_t m0 = (size_t)b * SEQ;
        r.Q = T.p + (m0 + r.P0) * INC + 448 + kvh * 256; r.K = T.ks + (size_t)it.bh * SEQ * 64; r.V = T.p + m0 * INC + 1088 + kvh * 64;
        r.O = T.mix + (m0 + r.P0) * 1024 + 512 + kvh * 256; r.SS = T.oss + (m0 + r.P0) * 16 + 8 + kvh * 4;
        r.sinks = T.sinks + kvh * 4;
    }
    return r;
}
template <class C> __device__ __forceinline__ void attn_phase(char* lds, const Tensors& T, int nbh, int G_, int c_, int wv) {
    float mfix;
    { const float* gq = C::SINK ? T.gq_swa : T.gq_mla; const float* gk = C::SINK ? T.gk_swa : T.gk_mla; const int ln = lane_id_v(); float mq = 0.f, mk = 0.f;
      for (int i = ln; i < C::DQK; i += 64) { mq = fmaxf(mq, fabsf(gq[i])); mk = fmaxf(mk, fabsf(gk[i])); }
      mq = fmaxf(mq, shx<1>(mq)); mq = fmaxf(mq, shx<2>(mq)); mq = fmaxf(mq, shx<4>(mq)); mq = fmaxf(mq, shx<8>(mq)); mq = fmaxf(mq, shx<16>(mq));
      mk = fmaxf(mk, shx<1>(mk)); mk = fmaxf(mk, shx<2>(mk)); mk = fmaxf(mk, shx<4>(mk)); mk = fmaxf(mk, shx<8>(mk)); mk = fmaxf(mk, shx<16>(mk));
      { auto r1 = __builtin_amdgcn_permlane32_swap(__float_as_uint(mq), __float_as_uint(mq), false, false); mq = fmaxf(__uint_as_float(r1[0]), __uint_as_float(r1[1]));
        auto r2 = __builtin_amdgcn_permlane32_swap(__float_as_uint(mk), __float_as_uint(mk), false, false); mk = fmaxf(__uint_as_float(r2[0]), __uint_as_float(r2[1])); }
      mfix = (float)C::DQK * mq * mk * 1.0001f; mfix = __uint_as_float(__builtin_amdgcn_readfirstlane(__float_as_uint(mfix))); }
    const int nqb = C::GQA4 ? SEQ / (2 * QBLK) : SEQ / QB, nramp = C::GQA4 ? 0 : swa_nramp(nqb, C::W), nx = (nramp + 1) / 2 + (nqb - nramp), total = nx * nbh;
    const int cv = (G_ % 8 == 0) ? (c_ % 8) * (G_ / 8) + c_ / 8 : c_;
    int L = cv; if (L >= total) return;
    Item it = decode(L, nqb, nx, nramp); int np = it.qb1 != it.qb0 ? 2 : 1, pass = 0; bool primed = false;
    BlockRef cur = make_ref<C>(T, it, 0);
    for (;;) {
        int Ln = L, passn = pass + 1; Item itn = it; bool has = true;
        if (passn >= np) { passn = 0; Ln = L + G_; if (Ln >= total) has = false; else itn = decode(Ln, nqb, nx, nramp); }
        const BlockRef nxt = has ? make_ref<C>(T, itn, passn) : cur;
        attn_block<C>(cur, lds, C::SINK ? T.gq_swa : T.gq_mla, T.rope, mfix, wv, nxt, has, primed);
        if (!has) break;
        primed = true; cur = nxt; L = Ln; it = itn; pass = passn; np = it.qb1 != it.qb0 ? 2 : 1;
    }
}
}

#define XB_TMO      128
#define XB_XCNT(j)  (256  + 64 * (j))
#define XB_XSUB(j)  (1280 + 64 * (j))
#define XB_XGEN(j)  (2304 + 64 * (j))
#define XB_TOP      3328
#define XB_TOPGEN   3392
#define XCD_BAR_WORDS 3456
#define XB_SPIN_CAP (1u << 18)
__device__ __forceinline__ unsigned xb_ld(unsigned* p)              { return __hip_atomic_load(p, __ATOMIC_RELAXED, __HIP_MEMORY_SCOPE_AGENT); }
__device__ __forceinline__ unsigned xb_add(unsigned* p, unsigned v) { return __hip_atomic_fetch_add(p, v, __ATOMIC_RELAXED, __HIP_MEMORY_SCOPE_AGENT); }
__device__ __forceinline__ unsigned xb_xcc_id() { return (unsigned)__builtin_amdgcn_s_getreg((3 << 11) | 20) & 0xFu; }
#define XB_SPIN(cond, bar) do { unsigned _sp = 0; while (cond) { __builtin_amdgcn_s_sleep(1); \
    if ((++_sp & 255u) == 0u) { if (xb_ld(&(bar)[XB_TMO])) break; if (_sp > XB_SPIN_CAP) { atomicAdd(&(bar)[XB_TMO], 1u); break; } } } } while (0)
struct XcdBarrier { unsigned* bar; unsigned x; volatile LAS unsigned* st; };
__device__ __forceinline__ XcdBarrier xcd_barrier_post(unsigned* bar, volatile LAS unsigned* st) {
    XcdBarrier b; b.bar = bar; b.x = xb_xcc_id(); b.st = st;
    if (threadIdx.x == 0) (void)xb_add(&bar[XB_XCNT(b.x)], 1u);
    return b;
}
__device__ __forceinline__ void xcd_barrier_complete(unsigned* bar, unsigned x, unsigned& nloc, unsigned& nx) {
    const unsigned G = gridDim.x * gridDim.y * gridDim.z;
    unsigned sum, cnt, mine, sp = 0u;
    for (;;) {
        sum = 0u; cnt = 0u; mine = 0u;
#pragma unroll
        for (unsigned j = 0; j < 16; ++j) { const unsigned c = xb_ld(&bar[XB_XCNT(j)]); sum += c; cnt += (c > 0u) ? 1u : 0u; mine = (j == x) ? c : mine; }
        if (sum == G) break;
        __builtin_amdgcn_s_sleep(1);
        if ((++sp & 255u) == 0u) { if (xb_ld(&bar[XB_TMO])) break; if (sp > XB_SPIN_CAP) { atomicAdd(&bar[XB_TMO], 1u); break; } }
    }
    nloc = mine > 0u ? mine : 1u; nx = cnt > 0u ? cnt : 1u;
}
__device__ __forceinline__ void xcd_barrier(const XcdBarrier& b, int wv) {
    asm volatile("s_waitcnt vmcnt(0)" ::: "memory");
    __syncthreads();
    if (wv == 0 && lane_id_v() == 0) {
        unsigned* bar = b.bar;
        __builtin_amdgcn_s_waitcnt(0);
        unsigned nloc = b.st[0], nx = b.st[1];
        if (nloc == 0u) { xcd_barrier_complete(bar, b.x, nloc, nx); b.st[0] = nloc; b.st[1] = nx; }
        const unsigned old = xb_add(&bar[XB_XSUB(b.x)], 1u);
        const unsigned gen = old / nloc;
        if (old + 1u == (gen + 1u) * nloc) {
            __builtin_amdgcn_fence(__ATOMIC_RELEASE, "agent");
            asm volatile("s_waitcnt vmcnt(0)" ::: "memory");
            const unsigned og = xb_add(&bar[XB_TOP], 1u);
            const unsigned tg = og / nx;
            if (og + 1u == (tg + 1u) * nx) xb_add(&bar[XB_TOPGEN], 1u);
            else XB_SPIN(xb_ld(&bar[XB_TOPGEN]) == tg, bar);
            __builtin_amdgcn_fence(__ATOMIC_ACQUIRE, "agent");
            xb_add(&bar[XB_XGEN(b.x)], 1u);
            asm volatile("s_waitcnt vmcnt(0)" ::: "memory");
        } else {
            XB_SPIN(xb_ld(&bar[XB_XGEN(b.x)]) == gen, bar);
            __builtin_amdgcn_fence(__ATOMIC_ACQUIRE, "agent");
            asm volatile("s_waitcnt vmcnt(0)" ::: "memory");
        }
    }
    __syncthreads();
}

struct Params { const float* in[23]; float* out; unsigned char* ws; int ph_lo, ph_hi; };

struct TJob { const float* W; const float* gain; bf16_t* WT; int K, N, ldt, coloff, rmap; };
struct TrIn { f32x4 wv[8]; float gs[8]; };
__device__ __forceinline__ void tr_load(const TJob& J, int item, int lane, TrIn& T) {
    const int nblk = J.N / 32, kb = item / nblk, nb = item % nblk, k0 = 64 * kb, n0 = 32 * nb;
#pragma unroll
    for (int i = 0; i < 8; ++i) { const int kk = 8 * i + (lane >> 3); T.wv[i] = *(const f32x4*)(J.W + (size_t)(k0 + kk) * J.N + n0 + (lane & 7) * 4); T.gs[i] = J.gain ? J.gain[k0 + kk] : 1.f; }
}
__device__ __forceinline__ void tr_proc(const TJob& J, LAS float* scr, int item, int lane, const TrIn& T) {
    const int nblk = J.N / 32, kb = item / nblk, nb = item % nblk, k0 = 64 * kb, n0 = 32 * nb;
#pragma unroll
    for (int i = 0; i < 8; ++i) { const int kk = 8 * i + (lane >> 3); LAS float* d = scr + kk * 33 + (lane & 7) * 4;
        d[0] = T.wv[i][0] * T.gs[i]; d[1] = T.wv[i][1] * T.gs[i]; d[2] = T.wv[i][2] * T.gs[i]; d[3] = T.wv[i][3] * T.gs[i]; }
    asm volatile("s_waitcnt lgkmcnt(0)" ::: "memory");
    const int c = lane & 7;
    int rb = n0;
    if (J.rmap) rb = 256 * (n0 >> 7) + (n0 & 127) + (J.rmap == 2 ? 128 : 0);
#pragma unroll
    for (int j = 0; j < 4; ++j) { const int n = (lane >> 3) + 8 * j; const LAS float* s = scr + (8 * c) * 33 + n;
        u32x4 o; o.x = cvt_pk_bf16(s[0 * 33], s[1 * 33]); o.y = cvt_pk_bf16(s[2 * 33], s[3 * 33]); o.z = cvt_pk_bf16(s[4 * 33], s[5 * 33]); o.w = cvt_pk_bf16(s[6 * 33], s[7 * 33]);
        *(u32x4*)(J.WT + (size_t)(rb + n) * J.ldt + J.coloff + k0 + 8 * c) = o; }
    asm volatile("s_waitcnt lgkmcnt(0)" ::: "memory");
}
__device__ __forceinline__ TJob get_job(const Params& P, int l, int j) {
    unsigned char* wl = P.ws + WS_W + (size_t)l * W_LAYER; TJob J; J.coloff = 0; J.rmap = 0;
    switch (j) {
    case 0: J.W = P.in[2] + (size_t)l * DM * DFF; J.gain = P.in[1] + l * DM; J.WT = (bf16_t*)(wl + OW_1T); J.K = DM; J.N = DFF; J.ldt = DM; J.rmap = 1; break;
    case 1: J.W = P.in[3] + (size_t)l * DM * DFF; J.gain = P.in[1] + l * DM; J.WT = (bf16_t*)(wl + OW_1T); J.K = DM; J.N = DFF; J.ldt = DM; J.rmap = 2; break;
    case 2: J.W = P.in[4] + (size_t)l * DFF * DM; J.gain = nullptr; J.WT = (bf16_t*)(wl + OW_1D); J.K = DFF; J.N = DM; J.ldt = DFF; break;
    case 3: J.W = P.in[20] + (size_t)l * DM * DFF; J.gain = P.in[19] + l * DM; J.WT = (bf16_t*)(wl + OW_2T); J.K = DM; J.N = DFF; J.ldt = DM; J.rmap = 1; break;
    case 4: J.W = P.in[21] + (size_t)l * DM * DFF; J.gain = P.in[19] + l * DM; J.WT = (bf16_t*)(wl + OW_2T); J.K = DM; J.N = DFF; J.ldt = DM; J.rmap = 2; break;
    case 5: J.W = P.in[22] + (size_t)l * DFF * DM; J.gain = nullptr; J.WT = (bf16_t*)(wl + OW_2D); J.K = DFF; J.N = DM; J.ldt = DFF; break;
    case 6: J.W = P.in[6] + (size_t)l * DM * INC; J.gain = P.in[5] + l * DM; J.WT = (bf16_t*)(wl + OW_IN); J.K = DM; J.N = INC; J.ldt = DM; break;
    case 7: J.W = P.in[8] + (size_t)l * 256 * 768; J.gain = P.in[7] + l * 256; J.WT = (bf16_t*)(wl + OW_QB); J.K = 256; J.N = 768; J.ldt = 256; break;
    case 8: J.W = P.in[10] + (size_t)l * 128 * 1024; J.gain = P.in[9] + l * 128; J.WT = (bf16_t*)(wl + OW_KVB); J.K = 128; J.N = 1024; J.ldt = 128; break;
    case 9: J.W = P.in[18] + (size_t)l * DM * DM; J.gain = P.in[16] + l * 512; J.WT = (bf16_t*)(wl + OW_O); J.K = 512; J.N = DM; J.ldt = DM; break;
    default: J.W = P.in[18] + (size_t)l * DM * DM + (size_t)512 * DM; J.gain = P.in[17] + l * 512; J.WT = (bf16_t*)(wl + OW_O); J.K = 512; J.N = DM; J.ldt = DM; J.coloff = 512; break;
    }
    return J;
}
__device__ __forceinline__ void prologue(const Params& P, LAS unsigned char* lds, int G, int wv) {
    const int lane = lane_id_v(), wave = wv;
    LAS float* scr = (LAS float*)(lds + wave * 16384);
    const int gw = blockIdx.x * NWAVES + wave, NGW = G * NWAVES;
    int rot = 0;
    TrIn cur; TJob Jc = get_job(P, 0, 0); int itc = 0; bool have = false;
    for (int l = 0; l < DEPTH; ++l)
        for (int j = 0; j < 11; ++j) {
            const TJob J = get_job(P, l, j);
            const int nit = (J.K / 64) * (J.N / 32);
            int first = gw - rot; if (first < 0) first += NGW;
#ifndef NO_TR
            for (int it = first; it < nit; it += NGW) {
                TrIn nx; tr_load(J, it, lane, nx);
                if (have) tr_proc(Jc, scr, itc, lane, cur);
                cur = nx; Jc = J; itc = it; have = true;
            }
#endif
            rot = (rot + nit) % NGW;
        }
    if (have) tr_proc(Jc, scr, itc, lane, cur);
    const float* x = P.in[0]; bf16_t* xb = (bf16_t*)(P.ws + WS_XB); float* xss = (float*)(P.ws + WS_XSS);
#ifndef NO_XB
    for (int m = gw; m < MTOK; m += 2 * NGW) {
        const int m2 = (m + NGW < MTOK) ? m + NGW : m;
        const f32x4* xr = (const f32x4*)(x + (size_t)m * DM) + lane; const f32x4* xr2 = (const f32x4*)(x + (size_t)m2 * DM) + lane; f32x4 v[4], v2[4]; float s = 0.f, s2 = 0.f;
#pragma unroll
        for (int j = 0; j < 4; ++j) v[j] = xr[64 * j];
#pragma unroll
        for (int j = 0; j < 4; ++j) v2[j] = xr2[64 * j];
#pragma unroll
        for (int j = 0; j < 4; ++j) { s += (v[j][0] * v[j][0] + v[j][1] * v[j][1]) + (v[j][2] * v[j][2] + v[j][3] * v[j][3]); s2 += (v2[j][0] * v2[j][0] + v2[j][1] * v2[j][1]) + (v2[j][2] * v2[j][2] + v2[j][3] * v2[j][3]); }
        s = wave_sum(s); s2 = wave_sum(s2);
        unsigned long long* o8 = (unsigned long long*)(xb + (size_t)m * DM) + lane; unsigned long long* o82 = (unsigned long long*)(xb + (size_t)m2 * DM) + lane;
#pragma unroll
        for (int j = 0; j < 4; ++j) o8[64 * j] = (unsigned long long)cvt_pk_bf16(v[j][0], v[j][1]) | ((unsigned long long)cvt_pk_bf16(v[j][2], v[j][3]) << 32);
        if (lane < 16) xss[(size_t)m * 16 + lane] = lane == 0 ? s : 0.f;
        if (m2 != m) {
#pragma unroll
            for (int j = 0; j < 4; ++j) o82[64 * j] = (unsigned long long)cvt_pk_bf16(v2[j][0], v2[j][1]) | ((unsigned long long)cvt_pk_bf16(v2[j][2], v2[j][3]) << 32);
            if (lane < 16) xss[(size_t)m2 * 16 + lane] = lane == 0 ? s2 : 0.f;
        }
    }
#endif
    { float2* rope = (float2*)(P.ws + WS_ROPE);
      for (int e = gw * 64 + lane; e < SEQ * 32; e += NGW * 64) { const int pos = e >> 5, i = e & 31;
          const float inv = 1.0f / powf(10000.0f, (float)(2 * i) / 64.0f); const float ang = (float)pos * inv;
          rope[e] = make_float2(cosf(ang), sinf(ang)); } }
}

__device__ __forceinline__ void ld8f(const bf16_t* p, float (&v)[8]) {
    const bf16x8 t = *reinterpret_cast<const bf16x8*>(p);
#pragma unroll
    for (int e = 0; e < 8; ++e) v[e] = bf2f((bf16_t)t[e]);
}
__device__ __forceinline__ void st8f(bf16_t* p, const float (&v)[8]) {
    u32x4 w; w.x = cvt_pk_bf16(v[0], v[1]); w.y = cvt_pk_bf16(v[2], v[3]); w.z = cvt_pk_bf16(v[4], v[5]); w.w = cvt_pk_bf16(v[6], v[7]);
    *(u32x4*)p = w;
}
__device__ __forceinline__ float ssq8(const float (&v)[8]) { return ((v[0] * v[0] + v[1] * v[1]) + (v[2] * v[2] + v[3] * v[3])) + ((v[4] * v[4] + v[5] * v[5]) + (v[6] * v[6] + v[7] * v[7])); }
__device__ __forceinline__ float bperm(float v, int src_lane) { return __uint_as_float((unsigned)__builtin_amdgcn_ds_bpermute(src_lane << 2, (int)__float_as_uint(v))); }
__device__ __forceinline__ float red8(float s) { s += shx<1>(s); s += shx<2>(s); s += shx<4>(s); return s; }
__device__ __forceinline__ void norm_rope(float (&v)[8], float rstd, const float (&g)[8], bool rope, const float (&cs)[8], const float (&sn)[8]) {
#pragma unroll
    for (int e = 0; e < 8; ++e) { v[e] *= rstd * g[e]; const float pr = shx<4>(v[e]); const float r = v[e] * cs[e] + pr * sn[e]; v[e] = rope ? r : v[e]; }
}
__device__ __forceinline__ void prep_phase(const Params& P, int l, int G, int wv) {
    const int lane = lane_id_v(), wave = wv;
    const int gw = blockIdx.x * NWAVES + wave, NGW = G * NWAVES;
    bf16_t* qakv = (bf16_t*)(P.ws + WS_QAKV); const bf16_t* pb = (const bf16_t*)(P.ws + WS_P);
    bf16_t* km = (bf16_t*)(P.ws + WS_KM); bf16_t* qs = (bf16_t*)(P.ws + WS_QS); bf16_t* ks = (bf16_t*)(P.ws + WS_KS);
    const float* rope = (const float*)(P.ws + WS_ROPE);
    const int hsub = lane / 24, c = lane - hsub * 24, c8 = lane & 7;
    const bool mact = lane < 48, mrope = c >= 16; const int hb = (hsub > 1 ? 1 : hsub) * 24;
    float gq[8], gk[8], gsq[8], gsk[8];
#pragma unroll
    for (int e = 0; e < 8; ++e) { gq[e] = P.in[11][l * 192 + c * 8 + e]; gk[e] = P.in[12][l * 192 + c * 8 + e]; gsq[e] = P.in[13][l * 64 + c8 * 8 + e]; gsk[e] = P.in[14][l * 64 + c8 * 8 + e]; }
    const float sgn = (c8 & 4) ? 1.f : -1.f;
    struct TokIn { f32x4 rt[4]; bf16x8 kp[2]; bf16x8 sk; };
    const int hs_ = hsub > 1 ? 1 : hsub;
#define LOADTOK(T_, m_) do { const int s_ = (m_) % SEQ; const f32x4* rt_ = (const f32x4*)(rope + (size_t)s_ * 64 + (c8 & 3) * 16);                          \
        _Pragma("unroll") for (int q = 0; q < 4; ++q) T_.rt[q] = rt_[q];                                                                                    \
        const bf16_t* qrow_ = qakv + (size_t)(m_) * 1792; const bf16_t* prow_ = pb + (size_t)(m_) * INC;                                                   \
        _Pragma("unroll") for (int p = 0; p < 2; ++p) T_.kp[p] = *reinterpret_cast<const bf16x8*>(mrope ? prow_ + 384 + (c - 16) * 8 : qrow_ + 768 + (2 * p + hs_) * 256 + c * 8); \
        T_.sk = *reinterpret_cast<const bf16x8*>(prow_ + 960 + (lane & 15) * 8); } while (0)
#define PROCTOK(T_, m_) do { const int b = (m_) / SEQ, s = (m_) % SEQ; float cs[8], sn[8];                                                                    \
        _Pragma("unroll") for (int q = 0; q < 4; ++q) { const f32x4 t = T_.rt[q]; cs[2 * q] = t[0]; sn[2 * q] = t[1] * sgn; cs[2 * q + 1] = t[2]; sn[2 * q + 1] = t[3] * sgn; } \
        _Pragma("unroll") for (int p = 0; p < 2; ++p) { const int h = 2 * p + hs_; float v[8];                                                                \
            _Pragma("unroll") for (int e = 0; e < 8; ++e) v[e] = bf2f((bf16_t)T_.kp[p][e]);                                                                \
            { const float t = red8(ssq8(v)); const float tot = bperm(t, hb) + bperm(t, hb + 8) + bperm(t, hb + 16);                                         \
              norm_rope(v, rsqrtf(tot * (1.f / 192.f) + EPS), gk, mrope, cs, sn); }                                                                          \
            if (mact) st8f(km + ((size_t)(b * 4 + h) * SEQ + s) * 192 + c * 8, v); }                                                                         \
        { float v[8]; const int lk = lane & 15;                                                                                                              \
          _Pragma("unroll") for (int e = 0; e < 8; ++e) v[e] = bf2f((bf16_t)T_.sk[e]);                                                                      \
          norm_rope(v, rsqrtf(red8(ssq8(v)) * (1.f / 64.f) + EPS), gsk, true, cs, sn);                                                                       \
          if (lane < 16) st8f(ks + ((size_t)(b * 2 + (lk >> 3)) * SEQ + s) * 64 + c8 * 8, v); } } while (0)
    for (int m = gw; m < MTOK; m += 4 * NGW) {
        TokIn A, B, C_, D_; const int m2 = m + NGW, m3 = m + 2 * NGW, m4 = m + 3 * NGW; const bool h2 = m2 < MTOK, h3 = m3 < MTOK, h4 = m4 < MTOK;
        LOADTOK(A, m); LOADTOK(B, (h2 ? m2 : m)); LOADTOK(C_, (h3 ? m3 : m)); LOADTOK(D_, (h4 ? m4 : m));
        PROCTOK(A, m);
        if (h2) PROCTOK(B, m2);
        if (h3) PROCTOK(C_, m3);
        if (h4) PROCTOK(D_, m4);
    }
#undef LOADTOK
#undef PROCTOK
}

constexpr int NPH = 1 + 9 * DEPTH;
__device__ __forceinline__ int gemm_count(int k) { return (k == 3) ? 2 : ((k == 4 || k == 5) ? 0 : 1); }
__device__ __forceinline__ void make_gemm(const Params& P, int l, int k, int gi, pg8::Gemm& g, pg8::Epi& E) {
    unsigned char* ws = P.ws; unsigned char* wl = ws + WS_W + (size_t)l * W_LAYER;
    bf16_t* xb = (bf16_t*)(ws + WS_XB); bf16_t* act = (bf16_t*)(ws + WS_ACT); bf16_t* pb = (bf16_t*)(ws + WS_P); bf16_t* qakv = (bf16_t*)(ws + WS_QAKV); bf16_t* mix = (bf16_t*)(ws + WS_MIX);
    float* xss = (float*)(ws + WS_XSS); float* css = (float*)(ws + WS_CSS); float* oss = (float*)(ws + WS_OSS);
    g.M = MTOK; E.stats = nullptr; E.np4 = 0; E.inv_n = 0.f; E.alpha = 1.f; E.res = nullptr; E.outf = nullptr; E.outb = nullptr; E.ldc = 0; E.ncols = 1 << 30; E.ssq = nullptr; E.wb = 0; E.mstats = nullptr; E.mid_t = -1;
    if (k == 0 || k == 7) {
        g.A = xb; g.lda = DM; g.Bt = (const bf16_t*)(wl + (k == 0 ? OW_1T : OW_2T)); g.ldb = DM; g.N = 2 * DFF; g.K = DM;
        E.mode = pg8::MODE_SWIGLU; E.stats = xss; E.np4 = 4; E.inv_n = 1.f / DM; E.outb = act; E.ldc = DFF;
    } else if (k == 1 || k == 8) {
        g.A = act; g.lda = DFF; g.Bt = (const bf16_t*)(wl + (k == 1 ? OW_1D : OW_2D)); g.ldb = DFF; g.N = DM; g.K = DFF;
        E.mode = pg8::MODE_RESID; E.alpha = 0.5f; E.res = (l == 0 && k == 1) ? P.in[0] : nullptr; E.outf = (l == DEPTH - 1 && k == 8) ? P.out : nullptr; E.outb = xb; E.ldc = DM; E.ssq = xss; E.wb = 1;
    } else if (k == 2) {
        g.A = xb; g.lda = DM; g.Bt = (const bf16_t*)(wl + OW_IN); g.ldb = DM; g.N = 1280; g.K = DM;
        E.mode = pg8::MODE_SCALE; E.stats = xss; E.np4 = 4; E.inv_n = 1.f / DM; E.outb = pb; E.ldc = INC; E.ncols = INC; E.ssq = css;
    } else if (k == 3) {
        E.mode = pg8::MODE_SCALE; E.np4 = 1; E.ldc = 1792;
        if (gi == 0) { g.A = pb; g.lda = INC; g.Bt = (const bf16_t*)(wl + OW_QB); g.ldb = 256; g.N = 768; g.K = 256; E.stats = css; E.inv_n = 1.f / 256.f; E.outb = qakv; }
        else { g.A = pb + 256; g.lda = INC; g.Bt = (const bf16_t*)(wl + OW_KVB); g.ldb = 128; g.N = 1024; g.K = 128; E.stats = css + 4; E.inv_n = 1.f / 128.f; E.outb = qakv + 768; }
    } else {
        E.mode = pg8::MODE_RESID; E.outb = xb; E.ssq = xss; E.wb = 1; E.ldc = DM; E.inv_n = 1.f / 512.f; E.stats = oss + 8; E.np4 = 2; E.mstats = oss; E.mid_t = 8;
        g.A = mix; g.lda = DM; g.Bt = (const bf16_t*)(wl + OW_O); g.ldb = DM; g.N = DM; g.K = DM;
    }
}

__global__ void __launch_bounds__(NTHR, 2) fwd_megakernel(Params P) {
    extern __shared__ __attribute__((aligned(16))) unsigned char lds[];
    cg::grid_group grid = cg::this_grid();
    const int G = gridDim.x;
    LAS unsigned char* ldsl = (LAS unsigned char*)lds;
    volatile LAS unsigned* bst = (volatile LAS unsigned*)(ldsl + 131072 + 512);
    const int wv = __builtin_amdgcn_readfirstlane((int)threadIdx.x >> 6);
    if (threadIdx.x < 2) bst[threadIdx.x] = 0u;
    __syncthreads();
    XcdBarrier xbar; xbar.bar = (unsigned*)(P.ws + WS_CTL); xbar.x = 0; xbar.st = bst;
    const bool coop = (P.ph_hi - P.ph_lo) > 1;
    if (coop) xbar = xcd_barrier_post((unsigned*)(P.ws + WS_CTL), bst);
    if (P.ph_lo < 0) grid.sync();
    int ph0 = P.ph_lo;
    if (ph0 == 0) {
        prologue(P, ldsl, G, wv);
        if (1 < P.ph_hi) xcd_barrier(xbar, wv);
        ph0 = 1;
    }
    for (int ph = ph0; ph < P.ph_hi; ++ph) {
        {
            const int l = (ph - 1) / 9, k = (ph - 1) % 9;
            if (k == 4) {
#ifndef NO_PREP
                prep_phase(P, l, G, wv);
#endif
            } else if (k == 5) {
                att::Tensors T; T.qakv = (const bf16_t*)(P.ws + WS_QAKV); T.km = (const bf16_t*)(P.ws + WS_KM); T.p = (const bf16_t*)(P.ws + WS_P);
                T.ks = (const bf16_t*)(P.ws + WS_KS); T.gq_mla = P.in[11] + l * 192; T.gq_swa = P.in[13] + l * 64; T.gk_mla = P.in[12] + l * 192; T.gk_swa = P.in[14] + l * 64; T.rope = (const float*)(P.ws + WS_ROPE); T.mix = (bf16_t*)(P.ws + WS_MIX); T.oss = (float*)(P.ws + WS_OSS); T.sinks = P.in[15] + l * 8;
#ifndef REP_MLA
#define REP_MLA 1
#endif
#ifndef REP_SWA
#define REP_SWA 1
#endif
#ifndef REP_K
#define REP_K -1
#endif
                for (int rep = 0; rep < REP_MLA; ++rep) att::attn_phase<att::CfgMLA>((char*)lds, T, BATCH * 4, G, (int)blockIdx.x, wv);
                for (int rep = 0; rep < REP_SWA; ++rep) att::attn_phase<att::CfgSWA>((char*)lds, T, BATCH * 2, G, (int)blockIdx.x, wv);
            } else {
                const int ng = gemm_count(k);
                const int nrep = ((k == REP_K) || (REP_K == 0 && k == 7)) ? 2 : 1;
                for (int gi = 0; gi < ng * nrep; ++gi) {
                    pg8::Gemm g; pg8::Epi E; make_gemm(P, l, k, gi % ng, g, E);
                    pg8::StaticOrder S; S.init(g.M, g.N, G, (int)blockIdx.x);
#ifndef NO_GEMM
                    pg8::gemm_phase(ldsl, g, S, E, wv);
#endif
                }
            }
        }
        if (ph + 1 < P.ph_hi) xcd_barrier(xbar, wv);
    }
}

#ifndef MK_SPLIT
#define MK_SPLIT 0
#endif
extern "C" void kernel_launch(void* const* d_in, const int* in_sizes, int n_in, void* d_out, int out_size, void* d_ws, size_t ws_size, hipStream_t stream) {
    static int grid = 0;
    if (grid == 0) {
        if (n_in != 23 || out_size != MTOK * DM || ws_size < WS_END) { fprintf(stderr, "kernel_launch: unexpected shapes: n_in %d out %d ws %zu (need %zu)\n", n_in, out_size, ws_size, (size_t)WS_END); grid = -1; return; }
        int dev = 0, cus = 0, per_cu = 0;
        (void)hipGetDevice(&dev); (void)hipDeviceGetAttribute(&cus, hipDeviceAttributeMultiprocessorCount, dev);
        if (hipFuncSetAttribute((const void*)fwd_megakernel, hipFuncAttributeMaxDynamicSharedMemorySize, LDS_BYTES) != hipSuccess) { fprintf(stderr, "kernel_launch: hipFuncSetAttribute failed\n"); grid = -1; return; }
        if (hipOccupancyMaxActiveBlocksPerMultiprocessor(&per_cu, (const void*)fwd_megakernel, NTHR, LDS_BYTES) != hipSuccess || per_cu < 1) { fprintf(stderr, "kernel_launch: occupancy query says %d\n", per_cu); per_cu = 1; }
        (void)hipGetLastError();
        grid = cus * 1;
        fprintf(stderr, "kernel_launch: grid %d (cus %d, per_cu %d)\n", grid, cus, per_cu);
    }
    if (grid < 0) return;
    Params p{};
    for (int i = 0; i < 23; ++i) p.in[i] = (const float*)d_in[i];
    p.out = (float*)d_out; p.ws = (unsigned char*)d_ws;
    if (hipMemsetAsync((char*)d_ws + WS_CTL, 0, CTL_BYTES, stream) != hipSuccess) { fprintf(stderr, "kernel_launch: memset failed\n"); return; }
#if MK_SPLIT
#ifndef MK_MAXPH
#define MK_MAXPH NPH
#endif
    for (int ph = 0; ph < MK_MAXPH; ++ph) {
        p.ph_lo = ph; p.ph_hi = ph + 1;
        hipLaunchKernelGGL(fwd_megakernel, dim3(grid), dim3(NTHR), LDS_BYTES, stream, p);
    }
#else
    p.ph_lo = 0; p.ph_hi = NPH;
    void* args[] = {&p};
    hipError_t e = hipLaunchCooperativeKernel((const void*)fwd_megakernel, dim3(grid), dim3(NTHR), args, LDS_BYTES, stream);
    if (e != hipSuccess) fprintf(stderr, "cooperative launch failed: %s (grid %d)\n", hipGetErrorString(e), grid);
#endif
}
```
